# Optimizing an MI355X kernel written in HIP

```python
import jax, jax.numpy as jnp
from jax import lax
import numpy as np

D_MODEL = 1024
BATCH = 8
SEQ = 2048
DEPTH = 1
DEC_BATCH = 128
DEC_SEQ = 4
PAST_LEN = 16384
PAGE_SIZE = 128

N_META = 16
D_RWKV = D_MODEL
HEAD_SIZE = 64
N_HEADS = D_RWKV // HEAD_SIZE
D_DECAY_LORA = 64
D_AAA_LORA = 64
D_GATE_LORA = 160
D_CONV = D_MODEL
CONV_W = 3
D_FF = 2816
RWKV_PROJ = 3 * D_RWKV + D_DECAY_LORA + D_AAA_LORA + D_GATE_LORA
SC_PROJ = 3 * D_CONV
GATE_PROJ = 2 * D_MODEL
P_TOTAL = RWKV_PROJ + SC_PROJ + GATE_PROJ
RMS_EPS = 1e-6
GN_EPS = 64e-5

kernel_name = "rwkv7_shortconv_gated_hybrid_step"

RWKV_SPLITS = [D_RWKV, 2 * D_RWKV, 3 * D_RWKV, 3 * D_RWKV + D_DECAY_LORA,
               3 * D_RWKV + D_DECAY_LORA + D_AAA_LORA]


def rms_norm(x, g):
    xf = x.astype(jnp.float32)
    y = xf * lax.rsqrt(jnp.mean(xf * xf, axis=-1, keepdims=True) + RMS_EPS)
    return (y * g.astype(jnp.float32)).astype(x.dtype)


def causal_dwconv(u, buf, w):
    T = u.shape[1]
    full = jnp.concatenate([buf.astype(u.dtype), u], axis=1)
    out = full[:, 0:T] * w[0]
    for i in range(1, CONV_W):
        out = out + full[:, i:i + T] * w[i]
    return out, full[:, -(CONV_W - 1):]


def wkv7_scan(S0, r, w, k, v, a, b):
    def step(S, inp):
        r_t, w_t, k_t, v_t, a_t, b_t = inp
        sa = jnp.einsum('bhij,bhj->bhi', S, a_t)
        S = (S * w_t[:, :, None, :] + sa[..., None] * b_t[:, :, None, :]
             + v_t[..., None] * k_t[:, :, None, :])
        y = jnp.einsum('bhij,bhj->bhi', S, r_t)
        return S, y
    seq = tuple(jnp.moveaxis(t, 1, 0) for t in (r, w, k, v, a, b))
    S, ys = lax.scan(step, S0, seq)
    return jnp.moveaxis(ys, 0, 1), S


def hybrid_layer(x, s_wkv, s_shift, s_sc, s_ffn, norm1_g, w_in, b_gate, mu_shift, w0,
                 w_decay_up, a0, w_aaa_up, w_gate_up, k_k, k_a, r_k, lnx_g, lnx_b,
                 w_branch_rwkv, w_branch_sc, conv_sc, w_out, norm2_g, w_up, conv_ffn, w_down):
    Bsz, T, _ = x.shape
    xn = rms_norm(x, norm1_g)
    p = xn @ w_in
    p_rwkv = p[..., :RWKV_PROJ]
    p_sc = p[..., RWKV_PROJ:RWKV_PROJ + SC_PROJ]
    p_gate = p[..., RWKV_PROJ + SC_PROJ:] + b_gate

    prev = jnp.concatenate([s_shift[:, None].astype(p.dtype), p_rwkv[:, :-1]], axis=1)
    xs = p_rwkv + (prev - p_rwkv) * mu_shift
    new_shift = p_rwkv[:, -1]
    r, k, v, xw, xa, xg = jnp.split(xs, RWKV_SPLITS, axis=-1)
    w = -jax.nn.softplus(-(w0 + jnp.tanh(xw) @ w_decay_up)) - 0.5
    a = jax.nn.sigmoid(a0 + xa @ w_aaa_up)
    g = jax.nn.sigmoid(xg) @ w_gate_up
    kk = (k * k_k).reshape(Bsz, T, N_HEADS, HEAD_SIZE).astype(jnp.float32)
    kk = kk / jnp.maximum(jnp.linalg.norm(kk, axis=-1, keepdims=True), 1e-12)
    k = k * (1 + (a - 1) * k_a)
    heads = lambda t: t.reshape(Bsz, T, N_HEADS, HEAD_SIZE).astype(jnp.float32)
    r_h, k_h, v_h, a_h = heads(r), heads(k), heads(v), heads(a)
    decay = jnp.exp(-jnp.exp(heads(w)))
    y, S = wkv7_scan(s_wkv.astype(jnp.float32), r_h, decay, k_h, v_h, -kk, kk * a_h)
    mu = jnp.mean(y, axis=-1, keepdims=True)
    var = jnp.mean(jnp.square(y - mu), axis=-1, keepdims=True)
    yn = ((y - mu) * lax.rsqrt(var + GN_EPS)).reshape(Bsz, T, D_RWKV)
    yn = yn * lnx_g.astype(jnp.float32) + lnx_b.astype(jnp.float32)
    bonus = jnp.sum(r_h * k_h * r_k.astype(jnp.float32), axis=-1, keepdims=True) * v_h
    o_a = ((yn + bonus.reshape(Bsz, T, D_RWKV)).astype(x.dtype) * g) @ w_branch_rwkv

    h, Bg, Cg = jnp.split(p_sc, 3, axis=-1)
    conv_out, new_sc = causal_dwconv(Cg * h, s_sc, conv_sc)
    o_b = (Bg * conv_out) @ w_branch_sc

    ga, gb = jnp.split(jax.nn.sigmoid(p_gate), 2, axis=-1)
    x = x + (ga * o_a + gb * o_b) @ w_out

    xn2 = rms_norm(x, norm2_g)
    up = xn2 @ w_up
    upc, new_ffn = causal_dwconv(up, s_ffn, conv_ffn)
    gate, val = jnp.split(upc, 2, axis=-1)
    x = x + (jax.nn.silu(gate) * val) @ w_down
    return x, S.astype(s_wkv.dtype), new_shift, new_sc, new_ffn


def trunk(x, s_wkv, s_shift, s_sc, s_ffn, layer_params, final_norm_g):
    new_wkv, new_shift, new_sc, new_ffn = [], [], [], []
    for l in range(DEPTH):
        x, a, b, c, d = hybrid_layer(x, s_wkv[l], s_shift[l], s_sc[l], s_ffn[l],
                                     *[prm[l] for prm in layer_params])
        new_wkv.append(a); new_shift.append(b); new_sc.append(c); new_ffn.append(d)
    y = rms_norm(x, final_norm_g)
    return y, jnp.stack(new_wkv), jnp.stack(new_shift), jnp.stack(new_sc), jnp.stack(new_ffn)


def setup_inputs(seed: int = 0) -> dict:
    key = jax.random.key(seed)
    ks = iter(jax.random.split(key, 40))
    nrm = lambda shape, s: jax.random.normal(next(ks), shape, jnp.float32) * s
    L = DEPTH
    return {
        "x_prompt": nrm((BATCH, SEQ, D_MODEL), 1.0),
        "x_sample": nrm((DEC_BATCH, DEC_SEQ, D_MODEL), 1.0),
        "state_wkv": nrm((L, DEC_BATCH, N_HEADS, HEAD_SIZE, HEAD_SIZE), 0.1),
        "state_shift": nrm((L, DEC_BATCH, RWKV_PROJ), 1.0),
        "state_sc_conv": nrm((L, DEC_BATCH, CONV_W - 1, D_CONV), 1.0),
        "state_ffn_conv": nrm((L, DEC_BATCH, CONV_W - 1, 2 * D_FF), 1.0),
        "meta_tokens": nrm((N_META, D_MODEL), 1.0),
        "norm1_g": 1.0 + nrm((L, D_MODEL), 0.02),
        "w_in": nrm((L, D_MODEL, P_TOTAL), D_MODEL ** -0.5),
        "b_gate": nrm((L, GATE_PROJ), 0.02),
        "mu_shift": jax.random.uniform(next(ks), (L, RWKV_PROJ), jnp.float32),
        "w0": nrm((L, D_RWKV), 0.5) - 0.5,
        "w_decay_up": nrm((L, D_DECAY_LORA, D_RWKV), 0.1 * D_DECAY_LORA ** -0.5),
        "a0": nrm((L, D_RWKV), 0.1),
        "w_aaa_up": nrm((L, D_AAA_LORA, D_RWKV), 0.1 * D_AAA_LORA ** -0.5),
        "w_gate_up": nrm((L, D_GATE_LORA, D_RWKV), D_GATE_LORA ** -0.5),
        "k_k": 0.85 + nrm((L, D_RWKV), 0.02),
        "k_a": 1.0 + nrm((L, D_RWKV), 0.02),
        "r_k": nrm((L, N_HEADS, HEAD_SIZE), 0.1),
        "lnx_g": 1.0 + nrm((L, D_RWKV), 0.02),
        "lnx_b": nrm((L, D_RWKV), 0.02),
        "w_branch_rwkv": nrm((L, D_RWKV, D_MODEL), D_RWKV ** -0.5),
        "w_branch_sc": nrm((L, D_CONV, D_MODEL), D_CONV ** -0.5),
        "conv_sc": nrm((L, CONV_W, D_CONV), CONV_W ** -0.5),
        "w_out": nrm((L, D_MODEL, D_MODEL), 0.5 * D_MODEL ** -0.5),
        "norm2_g": 1.0 + nrm((L, D_MODEL), 0.02),
        "w_up": nrm((L, D_MODEL, 2 * D_FF), D_MODEL ** -0.5),
        "conv_ffn": nrm((L, CONV_W, 2 * D_FF), CONV_W ** -0.5),
        "w_down": nrm((L, D_FF, D_MODEL), 0.5 * D_FF ** -0.5),
        "final_norm_g": 1.0 + nrm((D_MODEL,), 0.02),
    }


def reference(x_prompt, x_sample, state_wkv, state_shift, state_sc_conv, state_ffn_conv,
              meta_tokens, norm1_g, w_in, b_gate, mu_shift, w0, w_decay_up, a0, w_aaa_up,
              w_gate_up, k_k, k_a, r_k, lnx_g, lnx_b, w_branch_rwkv, w_branch_sc, conv_sc,
              w_out, norm2_g, w_up, conv_ffn, w_down, final_norm_g):
    layer_params = (norm1_g, w_in, b_gate, mu_shift, w0, w_decay_up, a0, w_aaa_up, w_gate_up,
                    k_k, k_a, r_k, lnx_g, lnx_b, w_branch_rwkv, w_branch_sc, conv_sc, w_out,
                    norm2_g, w_up, conv_ffn, w_down)
    dt = x_prompt.dtype
    Bp = x_prompt.shape[0]
    meta = jnp.broadcast_to(meta_tokens.astype(dt)[None], (Bp, N_META, D_MODEL))
    xp = jnp.concatenate([meta, x_prompt], axis=1)
    z_wkv = jnp.zeros((DEPTH, Bp, N_HEADS, HEAD_SIZE, HEAD_SIZE), dt)
    z_shift = jnp.zeros((DEPTH, Bp, RWKV_PROJ), dt)
    z_sc = jnp.zeros((DEPTH, Bp, CONV_W - 1, D_CONV), dt)
    z_ffn = jnp.zeros((DEPTH, Bp, CONV_W - 1, 2 * D_FF), dt)
    yp, wkv_p, shift_p, sc_p, ffn_p = trunk(xp, z_wkv, z_shift, z_sc, z_ffn, layer_params, final_norm_g)
    y_prompt = yp[:, N_META:]
    y_sample, wkv_s, shift_s, sc_s, ffn_s = trunk(x_sample, state_wkv, state_shift, state_sc_conv,
                                                  state_ffn_conv, layer_params, final_norm_g)
    return (y_prompt, y_sample, wkv_p, wkv_s, shift_p, shift_s, sc_p, sc_s, ffn_p, ffn_s)
```

```cpp
#include <hip/hip_runtime.h>
#include <hip/hip_cooperative_groups.h>
#include <stdint.h>
#include <stdio.h>
namespace cg = cooperative_groups;

#ifndef N_LAUNCH_MODE
#define N_LAUNCH_MODE 1
#endif

typedef _Float16 h16;
typedef _Float16 h16x8 __attribute__((ext_vector_type(8)));
typedef _Float16 h16x4 __attribute__((ext_vector_type(4)));
typedef float f32x16 __attribute__((ext_vector_type(16)));
typedef float f32x4 __attribute__((ext_vector_type(4)));
typedef float f32x2 __attribute__((ext_vector_type(2)));

#define FI __device__ __forceinline__

constexpr int DM = 1024;
constexpr int MTOK = 17024;
constexpr int TPR = 2064;
constexpr int NPTOK = 16512;
constexpr int RWP = 3360;
constexpr int PTOT = 8480;
constexpr int DFF = 2816;
constexpr int LAW = 320;
constexpr int NMT_H = 136;
constexpr int NMT = 133;

constexpr size_t O_YP = 0, O_YS = 16777216, O_WKV = 17301504, O_SH = 26214400, O_SC = 26671360, O_FFN = 26949888;

constexpr size_t WS_WIN = 0;
constexpr size_t WS_WA = 17563648, WS_WB = 19660800, WS_WO = 21757952;
constexpr size_t WS_WUP = 23855104, WS_WDN = 35389440;
constexpr size_t WS_WLD = 41156608, WS_WLA = 41287680, WS_WLG = 41418752;
constexpr size_t WS_B = 41811968;
constexpr size_t WS_A = 146407424;
constexpr size_t WS_C = 181272576;
constexpr size_t WS_D = 216137728;
constexpr size_t WS_E = 251002880;
constexpr size_t WS_END = 261898240;

struct Params {
  const float* in[30];
  float* out;
  char* ws;
  int ph_lo, ph_hi;
};

enum { I_XP = 0, I_XS, I_SWKV, I_SSH, I_SSC, I_SFFN, I_META, I_N1G, I_WIN, I_BG, I_MU, I_W0, I_WDEC, I_A0, I_WAAA,
       I_WGATE, I_KK, I_KA, I_RK, I_LNG, I_LNB, I_WBR, I_WBS, I_CSC, I_WOUT, I_N2G, I_WUP, I_CFFN, I_WDN, I_FNG };

FI float sigm(float x) { return __builtin_amdgcn_rcpf(1.f + __expf(-x)); }
FI float tanh_(float x) { return 1.f - 2.f * __builtin_amdgcn_rcpf(1.f + __expf(2.f * x)); }
FI float wave_sum(float v) {
#pragma unroll
  for (int o = 32; o; o >>= 1) v += __shfl_xor(v, o);
  return v;
}
FI float sum16(float v) {
#pragma unroll
  for (int o = 8; o; o >>= 1) v += __shfl_xor(v, o);
  return v;
}
FI float quad_sum(float v) {
  float t = __builtin_bit_cast(float, __builtin_amdgcn_update_dpp(0, __builtin_bit_cast(int, v), 0xB1, 0xF, 0xF, true));
  v += t;
  t = __builtin_bit_cast(float, __builtin_amdgcn_update_dpp(0, __builtin_bit_cast(int, v), 0x4E, 0xF, 0xF, true));
  return v + t;
}
struct Tok { int seq, t, T; };
FI Tok tokinfo(int m) {
  Tok k;
  if (m < NPTOK) { k.seq = m / TPR; k.t = m - k.seq * TPR; k.T = TPR; }
  else { int mm = m - NPTOK; k.seq = 8 + (mm >> 2); k.t = mm & 3; k.T = 4; }
  return k;
}
FI const float* xrow(const Params& p, int m) {
  if (m < NPTOK) {
    int s = m / TPR, t = m - s * TPR;
    return t < 16 ? p.in[I_META] + t * DM : p.in[I_XP] + ((size_t)s * 2048 + (t - 16)) * DM;
  }
  return p.in[I_XS] + (size_t)(m - NPTOK) * DM;
}

FI int swz(int row, int chunk) { return row * 128 + ((chunk ^ ((row >> 1) & 7)) << 4); }

FI void zero_acc(f32x4 (&acc)[4][4]) {
#pragma unroll
  for (int a = 0; a < 4; ++a)
#pragma unroll
    for (int b = 0; b < 4; ++b) acc[a][b] = f32x4{0.f, 0.f, 0.f, 0.f};
}

FI void mainloop(f32x4 (&acc)[4][4], const h16* __restrict__ A, int lda, int mbase,
                 const h16* __restrict__ BT, int ldb, int K, char* lds) {
  const int tid = threadIdx.x, lane = tid & 63, wave = tid >> 6, wr = wave >> 1, wc = wave & 1;
  uint32_t aoff[4], boff[4];
#pragma unroll
  for (int i = 0; i < 4; ++i) {
    const int row = wave * 32 + i * 8 + (lane >> 3);
    const int chunk = (lane & 7) ^ ((row >> 1) & 7);
    int m = mbase + row; m = m < 0 ? 0 : (m > MTOK - 1 ? MTOK - 1 : m);
    aoff[i] = (uint32_t)m * lda + chunk * 8;
    boff[i] = (uint32_t)row * ldb + chunk * 8;
  }
  const int ldsw = wave * 4096 + lane * 16;
#define ML_ISSUE(KT, BUF) do { _Pragma("unroll") for (int i = 0; i < 4; ++i) { \
    __builtin_amdgcn_global_load_lds((const unsigned*)(A + aoff[i] + (KT) * 64), (unsigned*)(lds + (BUF) * 32768 + ldsw + i * 1024), 16, 0, 0); \
    __builtin_amdgcn_global_load_lds((const unsigned*)(BT + boff[i] + (KT) * 64), (unsigned*)(lds + (BUF) * 32768 + 16384 + ldsw + i * 1024), 16, 0, 0); } } while (0)
  const int nk = K >> 6;
  const int rA0 = wr * 64 + (lane & 15), rB0 = wc * 64 + (lane & 15), hh = lane >> 4;
  ML_ISSUE(0, 0);
  for (int kt = 0; kt < nk; ++kt) {
    const int buf = kt & 1;
    asm volatile("s_waitcnt vmcnt(0)" ::: "memory");
    __syncthreads();
    if (kt + 1 < nk) ML_ISSUE(kt + 1, buf ^ 1);
    const char* la = lds + buf * 32768;
    const char* lb = la + 16384;
#pragma unroll
    for (int ks = 0; ks < 2; ++ks) {
      h16x8 a[4], b[4];
#pragma unroll
      for (int t = 0; t < 4; ++t) {
        a[t] = *(const h16x8*)(la + swz(rA0 + t * 16, ks * 4 + hh));
        b[t] = *(const h16x8*)(lb + swz(rB0 + t * 16, ks * 4 + hh));
      }
#pragma unroll
      for (int ti = 0; ti < 4; ++ti)
#pragma unroll
        for (int tj = 0; tj < 4; ++tj) acc[ti][tj] = __builtin_amdgcn_mfma_f32_16x16x32_f16(a[ti], b[tj], acc[ti][tj], 0, 0, 0);
    }
  }
  __syncthreads();
#undef ML_ISSUE
}

FI int swz32(int row, int chunk) { return row * 64 + ((chunk ^ ((0 - (row >> 2)) & 3)) << 4); }
FI void mainloop2(f32x4 (&acc)[4][4], f32x4 (&acc2)[4][4], const h16* __restrict__ A, int lda, int mbase,
                  const h16* __restrict__ BT1, const h16* __restrict__ BT2, int ldb, int K, char* lds) {
  const int tid = threadIdx.x, lane = tid & 63, wave = tid >> 6, wr = wave >> 1, wc = wave & 1;
  uint32_t aoff[2], boff[2];
#pragma unroll
  for (int i = 0; i < 2; ++i) {
    const int row = wave * 32 + i * 16 + (lane >> 2);
    const int chunk = (lane & 3) ^ ((0 - (row >> 2)) & 3);
    int m = mbase + row; m = m < 0 ? 0 : (m > MTOK - 1 ? MTOK - 1 : m);
    aoff[i] = (uint32_t)m * lda + chunk * 8;
    boff[i] = (uint32_t)row * ldb + chunk * 8;
  }
  const int ldsw = wave * 2048 + lane * 16;
#define ML2_ISSUE(KT, BUF) do { _Pragma("unroll") for (int i = 0; i < 2; ++i) { \
    __builtin_amdgcn_global_load_lds((const unsigned*)(A + aoff[i] + (KT) * 32), (unsigned*)(lds + (BUF) * 24576 + ldsw + i * 1024), 16, 0, 0); \
    __builtin_amdgcn_global_load_lds((const unsigned*)(BT1 + boff[i] + (KT) * 32), (unsigned*)(lds + (BUF) * 24576 + 8192 + ldsw + i * 1024), 16, 0, 0); \
    __builtin_amdgcn_global_load_lds((const unsigned*)(BT2 + boff[i] + (KT) * 32), (unsigned*)(lds + (BUF) * 24576 + 16384 + ldsw + i * 1024), 16, 0, 0); } } while (0)
  const int nk = K >> 5;
  const int rA0 = wr * 64 + (lane & 15), rB0 = wc * 64 + (lane & 15), hh = lane >> 4;
  ML2_ISSUE(0, 0);
  for (int kt = 0; kt < nk; ++kt) {
    const int buf = kt & 1;
    asm volatile("s_waitcnt vmcnt(0)" ::: "memory");
    __syncthreads();
    if (kt + 1 < nk) ML2_ISSUE(kt + 1, buf ^ 1);
    const char* la = lds + buf * 24576;
    const char* lb = la + 8192;
    const char* lc = la + 16384;
    {
      h16x8 a[4], b[4], c[4];
#pragma unroll
      for (int t = 0; t < 4; ++t) {
        a[t] = *(const h16x8*)(la + swz32(rA0 + t * 16, hh));
        b[t] = *(const h16x8*)(lb + swz32(rB0 + t * 16, hh));
        c[t] = *(const h16x8*)(lc + swz32(rB0 + t * 16, hh));
      }
#pragma unroll
      for (int ti = 0; ti < 4; ++ti)
#pragma unroll
        for (int tj = 0; tj < 4; ++tj) {
          acc[ti][tj] = __builtin_amdgcn_mfma_f32_16x16x32_f16(a[ti], b[tj], acc[ti][tj], 0, 0, 0);
          acc2[ti][tj] = __builtin_amdgcn_mfma_f32_16x16x32_f16(a[ti], c[tj], acc2[ti][tj], 0, 0, 0);
        }
    }
  }
  __syncthreads();
#undef ML2_ISSUE
}

#define CROW(ti, reg) (wr * 64 + (ti) * 16 + 4 * (lane >> 4) + (reg))
#define CCOL(tj) (wc * 64 + (tj) * 16 + (lane & 15))

FI void stage_acc(const f32x4 (&acc)[4][4], float* T) {
  const int tid = threadIdx.x, lane = tid & 63, wave = tid >> 6, wr = wave >> 1, wc = wave & 1;
#pragma unroll
  for (int ti = 0; ti < 4; ++ti)
#pragma unroll
    for (int tj = 0; tj < 4; ++tj)
#pragma unroll
      for (int r = 0; r < 4; ++r) T[CROW(ti, r) * 128 + CCOL(tj)] = acc[ti][tj][r];
}

FI int win_map(int dr) {
  if (dr < 3360) return dr;
  if (dr < 3456) return -1;
  if (dr < 4480) return 3360 + (dr - 3456);
  if (dr < 5504) return 5408 + (dr - 4480);
  if (dr < 6528) return 4384 + (dr - 5504);
  return 6432 + (dr - 6528);
}
FI void transpose_tile(const float* __restrict__ src, int ldsrc, int Ksrc, int Nsrc, int mode, int rt, int ktile,
                       h16* __restrict__ dst, int lddst, float* sm) {
  const int tid = threadIdx.x;
  {
    const int rr = tid & 63, kq = tid >> 6;
    const int dr = rt * 64 + rr;
    int col = mode ? win_map(dr) : (dr < Nsrc ? dr : -1);
#pragma unroll
    for (int i = 0; i < 16; ++i) {
      int kk = kq + 4 * i, k = ktile * 64 + kk;
      float v = (col >= 0 && k < Ksrc) ? src[(size_t)k * ldsrc + col] : 0.f;
      sm[kk * 65 + rr] = v;
    }
  }
  __syncthreads();
  {
    const int dr = tid >> 2, seg = tid & 3;
    h16x8 o0, o1;
#pragma unroll
    for (int j = 0; j < 8; ++j) { o0[j] = (h16)sm[(seg * 16 + j) * 65 + dr]; o1[j] = (h16)sm[(seg * 16 + 8 + j) * 65 + dr]; }
    h16* d = dst + (size_t)(rt * 64 + dr) * lddst + ktile * 64 + seg * 16;
    *(h16x8*)d = o0; *(h16x8*)(d + 8) = o1;
  }
  __syncthreads();
}

FI void rms_rows(const Params& p, int mode, const float* __restrict__ src, const float* __restrict__ g, h16* dsth, int gw, int nw) {
  const int lane = threadIdx.x & 63;
  for (int m = gw; m < MTOK; m += nw) {
    const float* row = mode == 0 ? xrow(p, m) : src + (size_t)m * DM;
    f32x4 v[4]; float ss = 0.f;
#pragma unroll
    for (int i = 0; i < 4; ++i) { v[i] = *(const f32x4*)(row + lane * 4 + 256 * i); ss += v[i].x * v[i].x + v[i].y * v[i].y + v[i].z * v[i].z + v[i].w * v[i].w; }
    ss = wave_sum(ss);
    const float rs = rsqrtf(ss * (1.f / DM) + 1e-6f);
    if (mode == 2) {
      float* o;
      if (m < NPTOK) { int s = m / TPR, t = m - s * TPR; if (t < 16) continue; o = p.out + O_YP + ((size_t)s * 2048 + (t - 16)) * DM; }
      else o = p.out + O_YS + (size_t)(m - NPTOK) * DM;
#pragma unroll
      for (int i = 0; i < 4; ++i) { f32x4 gg = *(const f32x4*)(g + lane * 4 + 256 * i); f32x4 r = v[i] * rs * gg; *(f32x4*)(o + lane * 4 + 256 * i) = r; }
    } else {
#pragma unroll
      for (int i = 0; i < 4; ++i) {
        f32x4 gg = *(const f32x4*)(g + lane * 4 + 256 * i); f32x4 r = v[i] * rs * gg;
        h16x4 h; h[0] = (h16)r.x; h[1] = (h16)r.y; h[2] = (h16)r.z; h[3] = (h16)r.w;
        *(h16x4*)(dsth + (size_t)m * DM + lane * 4 + 256 * i) = h;
      }
    }
  }
}

FI void transpose_item(const Params& p, float* sm, int it) {
  {
    int i = it;
    if (i < 2144) { transpose_tile(p.in[I_WIN], PTOT, 1024, PTOT, 1, i >> 4, i & 15, (h16*)(p.ws + WS_WIN), 1024, sm); return; }
    i -= 2144;
    if (i < 256) { transpose_tile(p.in[I_WBR], 1024, 1024, 1024, 0, i >> 4, i & 15, (h16*)(p.ws + WS_WA), 1024, sm); return; }
    i -= 256;
    if (i < 256) { transpose_tile(p.in[I_WBS], 1024, 1024, 1024, 0, i >> 4, i & 15, (h16*)(p.ws + WS_WB), 1024, sm); return; }
    i -= 256;
    if (i < 256) { transpose_tile(p.in[I_WOUT], 1024, 1024, 1024, 0, i >> 4, i & 15, (h16*)(p.ws + WS_WO), 1024, sm); return; }
    i -= 256;
    if (i < 1408) { transpose_tile(p.in[I_WUP], 5632, 1024, 5632, 0, i >> 4, i & 15, (h16*)(p.ws + WS_WUP), 1024, sm); return; }
    i -= 1408;
    if (i < 704) { transpose_tile(p.in[I_WDN], 1024, 2816, 1024, 0, i / 44, i % 44, (h16*)(p.ws + WS_WDN), 2816, sm); return; }
    i -= 704;
    if (i < 16) { transpose_tile(p.in[I_WDEC], 1024, 64, 1024, 0, i, 0, (h16*)(p.ws + WS_WLD), 64, sm); return; }
    i -= 16;
    if (i < 16) { transpose_tile(p.in[I_WAAA], 1024, 64, 1024, 0, i, 0, (h16*)(p.ws + WS_WLA), 64, sm); return; }
    i -= 16;
    transpose_tile(p.in[I_WGATE], 1024, 160, 1024, 0, i / 3, i % 3, (h16*)(p.ws + WS_WLG), 192, sm);
  }
}

FI void phase0(const Params& p, char* lds) {
  float* sm = (float*)lds;
  h16* ws = (h16*)p.ws;
  for (int it = blockIdx.x; it < 2144 + 80; it += gridDim.x) transpose_item(p, sm, it < 2144 ? it : it + 2880);
  (void)ws;
  rms_rows(p, 0, nullptr, p.in[I_N1G], (h16*)(p.ws + WS_A), blockIdx.x * 4 + (threadIdx.x >> 6), gridDim.x * 4);
}

struct F8 { f32x4 a, b; };
FI F8 ld16(const h16* q) { h16x8 v = *(const h16x8*)q; F8 r; r.a = f32x4{(float)v[0], (float)v[1], (float)v[2], (float)v[3]}; r.b = f32x4{(float)v[4], (float)v[5], (float)v[6], (float)v[7]}; return r; }
FI F8 ld32(const float* q) { F8 r; r.a = *(const f32x4*)q; r.b = *(const f32x4*)(q + 4); return r; }
FI F8 zero8() { F8 r; r.a = f32x4{0.f, 0.f, 0.f, 0.f}; r.b = r.a; return r; }
FI void st16(h16* q, const F8& v) { h16x8 h; h[0] = (h16)v.a.x; h[1] = (h16)v.a.y; h[2] = (h16)v.a.z; h[3] = (h16)v.a.w; h[4] = (h16)v.b.x; h[5] = (h16)v.b.y; h[6] = (h16)v.b.z; h[7] = (h16)v.b.w; *(h16x8*)q = h; }
FI void st32(float* q, const F8& v) { *(f32x4*)q = v.a; *(f32x4*)(q + 4) = v.b; }
FI void stage16(const f32x4 (&acc)[4][4], h16* T) {
  const int tid = threadIdx.x, lane = tid & 63, wave = tid >> 6, wr = wave >> 1, wc = wave & 1;
  typedef _Float16 h16p __attribute__((ext_vector_type(2)));
  unsigned short* Tu = (unsigned short*)T;
#pragma unroll
  for (int ti = 0; ti < 4; ++ti)
#pragma unroll
    for (int tj = 0; tj < 4; ++tj)
#pragma unroll
      for (int r = 0; r < 4; r += 2) {
        h16p h2; h2[0] = (h16)acc[ti][tj][r]; h2[1] = (h16)acc[ti][tj][r + 1];
        uint32_t u = __builtin_bit_cast(uint32_t, h2);
        asm volatile("" : "+v"(u));
        Tu[CROW(ti, r) * 128 + CCOL(tj)] = (unsigned short)u;
        Tu[CROW(ti, r + 1) * 128 + CCOL(tj)] = (unsigned short)(u >> 16);
      }
}
typedef _Float16 h16x2 __attribute__((ext_vector_type(2)));
FI void pack_acc(const f32x4 (&acc)[4][4], uint32_t (&pk)[4][4][2]) {
#pragma unroll
  for (int ti = 0; ti < 4; ++ti)
#pragma unroll
    for (int tj = 0; tj < 4; ++tj)
#pragma unroll
      for (int r = 0; r < 4; r += 2) {
        h16x2 h2; h2[0] = (h16)acc[ti][tj][r]; h2[1] = (h16)acc[ti][tj][r + 1];
        pk[ti][tj][r >> 1] = __builtin_bit_cast(uint32_t, h2);
      }
}
FI void stage16_pk(const uint32_t (&pk)[4][4][2], h16* T) {
  const int tid = threadIdx.x, lane = tid & 63, wave = tid >> 6, wr = wave >> 1, wc = wave & 1;
#pragma unroll
  for (int ti = 0; ti < 4; ++ti)
#pragma unroll
    for (int tj = 0; tj < 4; ++tj)
#pragma unroll
      for (int r = 0; r < 4; r += 2) {
        h16x2 h2 = __builtin_bit_cast(h16x2, pk[ti][tj][r >> 1]);
        T[CROW(ti, r) * 128 + CCOL(tj)] = h2[0];
        T[CROW(ti, r + 1) * 128 + CCOL(tj)] = h2[1];
      }
}
FI void conv_prev(const h16* T, int row, int c8, const Tok& k, const float* st  , int ld, F8& p1, F8& p2) {
  if (k.t >= 2) { p1 = ld16(T + (row - 1) * 128 + c8); p2 = ld16(T + (row - 2) * 128 + c8); }
  else if (k.t == 1) { p1 = ld16(T + (row - 1) * 128 + c8); p2 = k.seq >= 8 ? ld32(st + ld) : zero8(); }
  else { if (k.seq >= 8) { p1 = ld32(st + ld); p2 = ld32(st); } else { p1 = zero8(); p2 = zero8(); } }
}

FI h16x8 cvth(const F8& v) { h16x8 h; h[0] = (h16)v.a.x; h[1] = (h16)v.a.y; h[2] = (h16)v.a.z; h[3] = (h16)v.a.w; h[4] = (h16)v.b.x; h[5] = (h16)v.b.y; h[6] = (h16)v.b.z; h[7] = (h16)v.b.w; return h; }
FI F8 cvtf(const h16x8& v) { F8 r; r.a = f32x4{(float)v[0], (float)v[1], (float)v[2], (float)v[3]}; r.b = f32x4{(float)v[4], (float)v[5], (float)v[6], (float)v[7]}; return r; }
FI h16x8 zeroh() { h16x8 h; for (int i = 0; i < 8; ++i) h[i] = (h16)0.f; return h; }
FI void conv_prev16(const h16* T, int row, int c8, const Tok& k, const float* st  , int ld, h16x8& p1, h16x8& p2) {
  if (k.t >= 2) { p1 = *(const h16x8*)(T + (row - 1) * 128 + c8); p2 = *(const h16x8*)(T + (row - 2) * 128 + c8); }
  else if (k.t == 1) { p1 = *(const h16x8*)(T + (row - 1) * 128 + c8); p2 = k.seq >= 8 ? cvth(ld32(st + ld)) : zeroh(); }
  else { if (k.seq >= 8) { p1 = cvth(ld32(st + ld)); p2 = cvth(ld32(st)); } else { p1 = zeroh(); p2 = zeroh(); } }
}

FI void phase1(const Params& p, char* lds) {
  const int tid = threadIdx.x;
  const h16* XN = (const h16*)(p.ws + WS_A);
  const h16* WinT = (const h16*)(p.ws + WS_WIN);
  h16* PB = (h16*)(p.ws + WS_B);
  h16* ZB = (h16*)(p.ws + WS_C);
  h16* LA = (h16*)(p.ws + WS_E);
  const int c8 = (tid & 15) * 8, r0 = tid >> 4;
  for (int it = blockIdx.x; it < 35 * NMT_H; it += gridDim.x) {
    const int j = it / NMT_H, mt = it - j * NMT_H;
    const int mbase = mt * 126 - 2;
    {
      const int npass = j < 8 ? 3 : 1;
      uint32_t pk[4][4][2];
#pragma unroll 1
      for (int pass = 0; pass < npass; ++pass) {
        int brow;
        if (j < 8) brow = (pass == 0 ? 3456 : (pass == 1 ? 4480 : 5504)) + j * 128;
        else brow = (j - 8) * 128;
        f32x4 acc[4][4];
        zero_acc(acc);
        mainloop(acc, XN, DM, mbase, WinT + (size_t)brow * DM, DM, DM, lds);
        if (j < 8) {
          if (pass == 0) pack_acc(acc, pk);
          else if (pass == 1) {
#pragma unroll
            for (int ti = 0; ti < 4; ++ti)
#pragma unroll
              for (int tj = 0; tj < 4; ++tj)
#pragma unroll
                for (int r = 0; r < 4; r += 2) {
                  h16x2 h2 = __builtin_bit_cast(h16x2, pk[ti][tj][r >> 1]);
                  h2[0] = (h16)((float)h2[0] * acc[ti][tj][r]); h2[1] = (h16)((float)h2[1] * acc[ti][tj][r + 1]);
                  pk[ti][tj][r >> 1] = __builtin_bit_cast(uint32_t, h2);
                }
          } else { stage16_pk(pk, (h16*)lds); stage16(acc, (h16*)lds + 16384); }
        } else stage_acc(acc, (float*)lds);
      }
    }
    if (j < 8) {
      const int n0 = j * 128;
      h16* TU = (h16*)lds; h16* TB = TU + 16384;
      __syncthreads();
      const int ch = n0 + c8;
      const float* cw = p.in[I_CSC];
      const h16x8 w0 = cvth(ld32(cw + ch)), w1 = cvth(ld32(cw + 1024 + ch)), w2 = cvth(ld32(cw + 2048 + ch));
#pragma unroll 1
      for (int i = 0; i < 8; ++i) {
        const int row = r0 + 16 * i, m = mbase + row;
        if (row < 2 || m >= MTOK) continue;
        const Tok k = tokinfo(m);
        const h16x8 cur = *(const h16x8*)(TU + row * 128 + c8), bg = *(const h16x8*)(TB + row * 128 + c8);
        h16x8 p1, p2;
        conv_prev16(TU, row, c8, k, p.in[I_SSC] + (size_t)(k.seq - 8) * 2048 + ch, 1024, p1, p2);
        *(h16x8*)(ZB + (size_t)m * DM + ch) = bg * (w0 * p2 + w1 * p1 + w2 * cur);
        if (k.t >= k.T - 2) st32(p.out + O_SC + (size_t)k.seq * 2048 + (k.t - (k.T - 2)) * 1024 + ch, cvtf(cur));
      }
      __syncthreads();
    } else {
      const int n0 = (j - 8) * 128;
      float* T = (float*)lds;
      __syncthreads();
      const int n = n0 + c8;
      const F8 muv = n < RWP ? ld32(p.in[I_MU] + n) : zero8();
#pragma unroll 1
      for (int i = 0; i < 8; ++i) {
        const int row = r0 + 16 * i, m = mbase + row;
        if (row < 2 || m >= MTOK) continue;
        const Tok k = tokinfo(m);
        const F8 cur = ld32(T + row * 128 + c8);
        F8 prev;
        if (k.t >= 1) prev = ld32(T + (row - 1) * 128 + c8);
        else prev = (k.seq >= 8 && n < RWP) ? ld32(p.in[I_SSH] + (size_t)(k.seq - 8) * RWP + n) : zero8();
        F8 xs;
        xs.a = cur.a + (prev.a - cur.a) * muv.a;
        xs.b = cur.b + (prev.b - cur.b) * muv.b;
        if (n < 3072) st16(PB + (size_t)m * 3072 + n, xs);
        else {
          const int q = n - 3072;
          if (q < LAW) {
            F8 v;
            if (q < 64) { v.a = f32x4{tanh_(xs.a.x), tanh_(xs.a.y), tanh_(xs.a.z), tanh_(xs.a.w)}; v.b = f32x4{tanh_(xs.b.x), tanh_(xs.b.y), tanh_(xs.b.z), tanh_(xs.b.w)}; }
            else if (q < 128) v = xs;
            else if (q < 288) { v.a = f32x4{sigm(xs.a.x), sigm(xs.a.y), sigm(xs.a.z), sigm(xs.a.w)}; v.b = f32x4{sigm(xs.b.x), sigm(xs.b.y), sigm(xs.b.z), sigm(xs.b.w)}; }
            else v = zero8();
            st16(LA + (size_t)m * LAW + q, v);
          }
        }
        if (n < RWP && k.t == k.T - 1) st32(p.out + O_SH + (size_t)k.seq * RWP + n, cur);
      }
      __syncthreads();
    }
  }
}

template <int CTRL> FI float dpp_mov(float v) { return __builtin_bit_cast(float, __builtin_amdgcn_update_dpp(0, __builtin_bit_cast(int, v), CTRL, 0xF, 0xF, true)); }
FI float row8_sum(float v) { v += dpp_mov<0xB1>(v); v += dpp_mov<0x4E>(v); v += dpp_mov<0x141>(v); return v; }
FI float row16_sum(float v) { v = row8_sum(v); v += dpp_mov<0x140>(v); return v; }

constexpr size_t OUT_Y_BYTES = 34865152;
constexpr size_t WS_YS = WS_END + 65536;
FI h16* yrow(const Params& p, int m) {
  return m < NPTOK ? (h16*)((char*)p.out + OUT_Y_BYTES) + (size_t)m * DM : (h16*)(p.ws + WS_YS) + (size_t)(m - NPTOK) * DM;
}

FI void phaseA(const Params& p, char* lds) {
  const int tid = threadIdx.x, lane = tid & 63, wave = tid >> 6, wr = wave >> 1, wc = wave & 1;
  const h16* LA = (const h16*)(p.ws + WS_E);
  h16* DA = (h16*)p.out;
  h16* AA = (h16*)(p.ws + WS_D);
  for (int it = blockIdx.x; it < 16 * NMT; it += gridDim.x) {
    const int j = it / NMT, mt = it - j * NMT;
    const int mbase = mt * 128, which = j >> 3, n0 = (j & 7) * 128;
    f32x4 acc[4][4];
    zero_acc(acc);
    if (which == 0) mainloop(acc, LA, LAW, mbase, (const h16*)(p.ws + WS_WLD) + (size_t)n0 * 64, 64, 64, lds);
    else mainloop(acc, LA + 64, LAW, mbase, (const h16*)(p.ws + WS_WLA) + (size_t)n0 * 64, 64, 64, lds);
    h16* dst = which == 0 ? DA : AA;
    stage_acc(acc, (float*)lds);
    __syncthreads();
    if (which == 0) {
      const float* T = (const float*)lds;
      const int ci = tid >> 5, cq = (tid & 31) * 4, n = n0 + cq;
      const f32x4 bias = *(const f32x4*)(p.in[I_W0] + n);
      f32x4 run = {1.f, 1.f, 1.f, 1.f};
#pragma unroll 1
      for (int rr = 0; rr < 16; ++rr) {
        const int row = ci * 16 + rr, m = mbase + row;
        if (m >= NPTOK && (m & 3) == 0) run = f32x4{1.f, 1.f, 1.f, 1.f};
        const f32x4 x = *(const f32x4*)(T + row * 128 + cq) + bias;
        run = run * f32x4{__expf(-0.60653066f * sigm(x.x)), __expf(-0.60653066f * sigm(x.y)), __expf(-0.60653066f * sigm(x.z)), __expf(-0.60653066f * sigm(x.w))};
        h16x4 h; h[0] = (h16)run.x; h[1] = (h16)run.y; h[2] = (h16)run.z; h[3] = (h16)run.w;
        *(h16x4*)(dst + (size_t)m * DM + n) = h;
      }
    } else {
      const float* T = (const float*)lds;
      const int c8 = (tid & 15) * 8, r0 = tid >> 4, n = n0 + c8;
      const float* w0p = p.in[I_W0]; const float* a0p = p.in[I_A0];
      const F8 bias = ld32((which == 0 ? w0p : a0p) + n);
#pragma unroll 1
      for (int i = 0; i < 8; ++i) {
        const int row = r0 + 16 * i, m = mbase + row;
        const F8 a = ld32(T + row * 128 + c8);
        const f32x4 xa = a.a + bias.a, xb = a.b + bias.b;
        F8 o;
        o.a = f32x4{sigm(xa.x), sigm(xa.y), sigm(xa.z), sigm(xa.w)}; o.b = f32x4{sigm(xb.x), sigm(xb.y), sigm(xb.z), sigm(xb.w)};
        if (which == 0) {
          o.a = f32x4{__expf(-0.60653066f * o.a.x), __expf(-0.60653066f * o.a.y), __expf(-0.60653066f * o.a.z), __expf(-0.60653066f * o.a.w)};
          o.b = f32x4{__expf(-0.60653066f * o.b.x), __expf(-0.60653066f * o.b.y), __expf(-0.60653066f * o.b.z), __expf(-0.60653066f * o.b.w)};
        }
        st16(dst + (size_t)m * DM + n, o);
      }
    }
    __syncthreads();
  }
}

FI void scan_unit(const Params& p, float* sm, int seq, int head, int half) {
  const int tid = threadIdx.x;
  const int T = seq < 8 ? TPR : 4;
  const int mseq = seq < 8 ? seq * TPR : NPTOK + (seq - 8) * 4;
  const h16* PB = (const h16*)(p.ws + WS_B);
  const h16* DA = (const h16*)p.out;
  const h16* AA = (const h16*)(p.ws + WS_D);
  const int rp = tid >> 4, cb = tid & 15;
  const int chp = head * 64 + cb * 4;
  const int row0 = half * 32 + rp * 2;
  f32x2 S0a, S0b, S1a, S1b;
  if (seq >= 8) {
    const float* sp = p.in[I_SWKV] + ((size_t)(seq - 8) * 16 + head) * 4096 + row0 * 64 + cb * 4;
    const f32x4 u = *(const f32x4*)sp, w = *(const f32x4*)(sp + 64);
    S0a = f32x2{u.x, u.y}; S0b = f32x2{u.z, u.w}; S1a = f32x2{w.x, w.y}; S1b = f32x2{w.z, w.w};
  } else { S0a = f32x2{0.f, 0.f}; S0b = S0a; S1a = S0a; S1b = S0a; }
  const f32x4 kkc = *(const f32x4*)(p.in[I_KK] + chp), kac = *(const f32x4*)(p.in[I_KA] + chp);
  const int nch = (T + 15) >> 4;
  h16x2* YP = (h16x2*)(sm + 12288);
  h16x4 Apr, Apk, Apv, Apd, Apa, Ape, Bpr, Bpk, Bpv, Bpd, Bpa, Bpe, Cpr, Cpk, Cpv, Cpd, Cpa, Cpe;
#define SC_LOAD(P, T0) do { int mp = (T0) + rp; if (mp > T - 1) mp = T - 1; const size_t mm = (size_t)(mseq + mp); \
    const h16* pp = PB + mm * 3072 + chp; P##pr = *(const h16x4*)pp; P##pk = *(const h16x4*)(pp + 1024); P##pv = *(const h16x4*)(pp + 2048); \
    P##pd = *(const h16x4*)(DA + mm * DM + chp); P##pa = *(const h16x4*)(AA + mm * DM + chp); \
    P##pe = *(const h16x4*)(DA + (mm - (rp > 0 ? 1 : 0)) * DM + chp); } while (0)
#define SC_PREP(P, BUF) do { float* bb = sm + (BUF) * 6144; \
    const f32x4 r4 = {(float)P##pr[0], (float)P##pr[1], (float)P##pr[2], (float)P##pr[3]}; \
    const f32x4 k4 = {(float)P##pk[0], (float)P##pk[1], (float)P##pk[2], (float)P##pk[3]}; \
    const f32x4 v4 = {(float)P##pv[0], (float)P##pv[1], (float)P##pv[2], (float)P##pv[3]}; \
    const f32x4 lam = {(float)P##pd[0], (float)P##pd[1], (float)P##pd[2], (float)P##pd[3]}; \
    f32x4 lam1 = {(float)P##pe[0], (float)P##pe[1], (float)P##pe[2], (float)P##pe[3]}; \
    if (rp == 0) lam1 = f32x4{1.f, 1.f, 1.f, 1.f}; \
    const f32x4 linv = f32x4{__builtin_amdgcn_rcpf(lam.x), __builtin_amdgcn_rcpf(lam.y), __builtin_amdgcn_rcpf(lam.z), __builtin_amdgcn_rcpf(lam.w)}; \
    const f32x4 a4 = {(float)P##pa[0], (float)P##pa[1], (float)P##pa[2], (float)P##pa[3]}; \
    const f32x4 kkv = k4 * kkc; \
    const float ss = row16_sum(kkv.x * kkv.x + kkv.y * kkv.y + kkv.z * kkv.z + kkv.w * kkv.w); \
    const f32x4 kk = kkv * __builtin_amdgcn_rcpf(fmaxf(__builtin_amdgcn_sqrtf(ss), 1e-12f)); \
    const int o = rp * 64 + cb * 4; \
      \
    *(f32x4*)(bb + o) = r4 * lam; *(f32x4*)(bb + 1024 + o) = lam; *(f32x4*)(bb + 2048 + o) = k4 * (1.f + (a4 - 1.f) * kac) * linv; \
    *(f32x4*)(bb + 3072 + o) = v4; *(f32x4*)(bb + 4096 + o) = -kk * lam1; *(f32x4*)(bb + 5120 + o) = kk * a4 * linv; } while (0)
#define ST_LOAD(X, TT) do { const float* q_ = bb + (TT) * 64 + cb * 4; \
    X##a = *(const f32x4*)(q_ + 4096); X##b = *(const f32x4*)(q_ + 5120); \
    X##k = *(const f32x4*)(q_ + 2048); X##r = *(const f32x4*)q_; X##v = *(const f32x2*)(bb + 3072 + (TT) * 64 + row0); } while (0)
#define LO(v) f32x2{(v).x, (v).y}
#define HI(v) f32x2{(v).z, (v).w}
#define ST_COMP(X, TT) do { \
    f32x2 s0_ = S0a * LO(X##a), s1_ = S1a * LO(X##a); s0_ = S0b * HI(X##a) + s0_; s1_ = S1b * HI(X##a) + s1_; \
    const f32x2 v0_ = {X##v.x, X##v.x}, v1_ = {X##v.y, X##v.y}; \
    const f32x2 u0a_ = LO(X##k) * v0_ + S0a, u0b_ = HI(X##k) * v0_ + S0b; \
    const f32x2 u1a_ = LO(X##k) * v1_ + S1a, u1b_ = HI(X##k) * v1_ + S1b; \
    const float sa0_ = row16_sum(s0_.x + s0_.y), sa1_ = row16_sum(s1_.x + s1_.y); \
    const f32x2 q0_ = {sa0_, sa0_}, q1_ = {sa1_, sa1_}; \
    S0a = LO(X##b) * q0_ + u0a_; S0b = HI(X##b) * q0_ + u0b_; S1a = LO(X##b) * q1_ + u1a_; S1b = HI(X##b) * q1_ + u1b_; \
    f32x2 y0_ = S0a * LO(X##r), y1_ = S1a * LO(X##r); y0_ = S0b * HI(X##r) + y0_; y1_ = S1b * HI(X##r) + y1_; \
    { h16x2 yp_; yp_[0] = (h16)(y0_.x + y0_.y); yp_[1] = (h16)(y1_.x + y1_.y); YP[(TT) * 256 + tid] = yp_; } } while (0)
#define SC_BODY(c, LSET, PSET) do { \
    const int t0 = (c) * 16; \
    const int nt = (T - t0) < 16 ? (T - t0) : 16;       \
    const float* bb = sm + ((c) & 1) * 6144; \
    if ((c) + 3 < nch) SC_LOAD(LSET, t0 + 48); \
    { \
      f32x4 Aa, Ab, Ak, Ar; f32x2 Av; \
      f32x4 Ba, Bb, Bk, Br; f32x2 Bv; \
      ST_LOAD(A, 0); \
      for (int tt = 0; tt < nt; tt += 2) { \
        ST_LOAD(B, tt + 1); \
        ST_COMP(A, tt); \
        const int tn = tt + 2 < nt ? tt + 2 : tt; \
        ST_LOAD(A, tn); \
        ST_COMP(B, tt + 1); \
      } \
    } \
    {   \
      const f32x4 ll_ = *(const f32x4*)(bb + 1024 + (nt - 1) * 64 + cb * 4); \
      S0a = S0a * LO(ll_); S0b = S0b * HI(ll_); S1a = S1a * LO(ll_); S1b = S1b * HI(ll_); } \
    __syncthreads(); \
    if (rp < nt) {     \
      const uint4* q_ = (const uint4*)(YP + rp * 256 + cb * 16); \
      float a0_ = 0.f, a1_ = 0.f; \
      _Pragma("unroll") for (int e_ = 0; e_ < 4; ++e_) { \
        const uint4 w_ = q_[e_]; \
        const h16x2 p0_ = __builtin_bit_cast(h16x2, w_.x), p1_ = __builtin_bit_cast(h16x2, w_.y), p2_ = __builtin_bit_cast(h16x2, w_.z), p3_ = __builtin_bit_cast(h16x2, w_.w); \
        a0_ += ((float)p0_[0] + (float)p1_[0]) + ((float)p2_[0] + (float)p3_[0]); \
        a1_ += ((float)p0_[1] + (float)p1_[1]) + ((float)p2_[1] + (float)p3_[1]); \
      } \
      h16x2 yh; yh[0] = (h16)a0_; yh[1] = (h16)a1_; \
      *(h16x2*)(yrow(p, mseq + t0 + rp) + head * 64 + half * 32 + cb * 2) = yh; \
    } \
    if ((c) + 1 < nch) SC_PREP(PSET, ((c) + 1) & 1);     \
    __syncthreads(); } while (0)
  SC_LOAD(A, 0);
  if (nch > 1) { SC_LOAD(B, 16); SC_LOAD(C, 32); }
  SC_PREP(A, 0);
  __syncthreads();
  for (int c = 0; c < nch; c += 3) {
    SC_BODY(c, A, B);
    if (c + 1 < nch) SC_BODY(c + 1, B, C);
    if (c + 2 < nch) SC_BODY(c + 2, C, A);
  }
#undef SC_BODY
  {
    float* op = p.out + O_WKV + ((size_t)seq * 16 + head) * 4096 + row0 * 64 + cb * 4;
    *(f32x4*)op = f32x4{S0a.x, S0a.y, S0b.x, S0b.y}; *(f32x4*)(op + 64) = f32x4{S1a.x, S1a.y, S1b.x, S1b.y};
  }
  __syncthreads();
#undef SC_LOAD
#undef SC_PREP
#undef ST_LOAD
#undef ST_COMP
#undef LO
#undef HI
}

FI void phase3(const Params& p, char* lds) {
  float* sm = (float*)lds;
  const int G = gridDim.x, b = blockIdx.x;
  for (int u = b; u < 256; u += G) scan_unit(p, sm, u >> 5, (u >> 1) & 15, u & 1);
  if (G > 256) {
    if (b >= 256) {
      for (int u = b - 256; u < 4096; u += G - 256) scan_unit(p, sm, 8 + (u >> 5), (u >> 1) & 15, u & 1);
      for (int it = 2144 + (b - 256); it < 5024; it += G - 256) transpose_item(p, sm, it);
    }
  }
  else {
    for (int u = b; u < 4096; u += G) scan_unit(p, sm, 8 + (u >> 5), (u >> 1) & 15, u & 1);
    for (int it = 2144 + b; it < 5024; it += G) transpose_item(p, sm, it);
  }
}

FI void phase3b(const Params& p, char* lds) {
  const int tid = threadIdx.x;
  const h16* LA = (const h16*)(p.ws + WS_E);
  const h16* PB = (const h16*)(p.ws + WS_B);
  h16* AZ = (h16*)(p.ws + WS_D);
  h16* TG = (h16*)lds;
  const int c8 = (tid & 15) * 8, r0 = tid >> 4;
  for (int it = blockIdx.x; it < 8 * NMT; it += gridDim.x) {
    const int j = it / NMT, mt = it - j * NMT;
    const int mbase = mt * 128, n0 = j * 128;
    {
      f32x4 acc[4][4];
      zero_acc(acc);
      mainloop(acc, LA + 128, LAW, mbase, (const h16*)(p.ws + WS_WLG) + (size_t)n0 * 192, 192, 192, lds);
      stage16(acc, TG);
    }
    __syncthreads();
    const int ch = n0 + c8;
    const F8 kac = ld32(p.in[I_KA] + ch), rkc = ld32(p.in[I_RK] + ch), lg = ld32(p.in[I_LNG] + ch), lb = ld32(p.in[I_LNB] + ch);
#pragma unroll 1
    for (int i = 0; i < 8; ++i) {
      const int row = r0 + 16 * i, m = mbase + row;
      const F8 y = ld16(yrow(p, m) + ch);
      const h16* pp = PB + (size_t)m * 3072 + ch;
      const F8 r = ld16(pp), k = ld16(pp + 1024), v = ld16(pp + 2048);
      const F8 a = ld16(AZ + (size_t)m * DM + ch), g = ld16(TG + row * 128 + c8);
      F8 kp; kp.a = k.a * (1.f + (a.a - 1.f) * kac.a); kp.b = k.b * (1.f + (a.b - 1.f) * kac.b);
      const f32x4 rk4 = r.a * kp.a * rkc.a + r.b * kp.b * rkc.b;
      const float rk = row8_sum((rk4.x + rk4.y) + (rk4.z + rk4.w));
      const f32x4 ys = y.a + y.b;
      const float mean = row8_sum((ys.x + ys.y) + (ys.z + ys.w)) * (1.f / 64.f);
      F8 d; d.a = y.a - mean; d.b = y.b - mean;
      const f32x4 d2 = d.a * d.a + d.b * d.b;
      const float var = row8_sum((d2.x + d2.y) + (d2.z + d2.w)) * (1.f / 64.f);
      const float rs = rsqrtf(var + 64e-5f);
      F8 z;
      z.a = (d.a * rs * lg.a + lb.a + v.a * rk) * g.a;
      z.b = (d.b * rs * lg.b + lb.b + v.b * rk) * g.b;
      st16(AZ + (size_t)m * DM + ch, z);
    }
    __syncthreads();
  }
}

FI void phase4(const Params& p, char* lds) {
  const int tid = threadIdx.x;
  const h16* XN = (const h16*)(p.ws + WS_A);
  const h16* ZA = (const h16*)(p.ws + WS_D);
  const h16* ZB = (const h16*)(p.ws + WS_C);
  const h16* WinT = (const h16*)(p.ws + WS_WIN);
  const h16* WA = (const h16*)(p.ws + WS_WA);
  const h16* WB = (const h16*)(p.ws + WS_WB);
  h16* MG = (h16*)(p.ws + WS_B);
  h16* G2 = (h16*)(p.ws + WS_B + OUT_Y_BYTES);
  h16* T0 = (h16*)lds; h16* T1 = T0 + 16384;
  const int c8 = (tid & 15) * 8, r0 = tid >> 4;
  for (int it = blockIdx.x; it < 8 * NMT; it += gridDim.x) {
    const int j = it / NMT, mt = it - j * NMT;
    const int mbase = mt * 128, n0 = j * 128, n = n0 + c8;
    {
      f32x4 acc[4][4], acc2[4][4];
      zero_acc(acc); zero_acc(acc2);
      mainloop2(acc, acc2, XN, DM, mbase, WinT + (size_t)(6528 + n0) * DM, WinT + (size_t)(7552 + n0) * DM, DM, DM, lds);
      stage16(acc, T0); stage16(acc2, T1);
    }
    __syncthreads();
    {
      const F8 ba = ld32(p.in[I_BG] + n), bb = ld32(p.in[I_BG] + 1024 + n);
#pragma unroll 1
      for (int i = 0; i < 8; ++i) {
        const int row = r0 + 16 * i; const size_t o = (size_t)(mbase + row) * DM + n;
        const F8 a = ld16(T0 + row * 128 + c8), b = ld16(T1 + row * 128 + c8);
        const f32x4 xa = a.a + ba.a, xb = a.b + ba.b, ya = b.a + bb.a, yb = b.b + bb.b;
        F8 ga, gb;
        ga.a = f32x4{sigm(xa.x), sigm(xa.y), sigm(xa.z), sigm(xa.w)}; ga.b = f32x4{sigm(xb.x), sigm(xb.y), sigm(xb.z), sigm(xb.w)};
        gb.a = f32x4{sigm(ya.x), sigm(ya.y), sigm(ya.z), sigm(ya.w)}; gb.b = f32x4{sigm(yb.x), sigm(yb.y), sigm(yb.z), sigm(yb.w)};
        st16(MG + o, ga); st16(G2 + o, gb);
      }
    }
    __syncthreads();
  }
  for (int it = blockIdx.x; it < 8 * NMT; it += gridDim.x) {
    const int j = it / NMT, mt = it - j * NMT;
    const int mbase = mt * 128, n0 = j * 128, n = n0 + c8;
    {
      uint32_t pk[4][4][2];
#pragma unroll 1
      for (int pass = 0; pass < 2; ++pass) {
        f32x4 acc[4][4];
        zero_acc(acc);
        mainloop(acc, pass == 0 ? ZA : ZB, DM, mbase, (pass == 0 ? WA : WB) + (size_t)n0 * DM, DM, DM, lds);
        if (pass == 0) pack_acc(acc, pk);
        else { stage16_pk(pk, T0); stage16(acc, T1); }
      }
    }
    __syncthreads();
#pragma unroll 1
    for (int i = 0; i < 8; ++i) {
      const int row = r0 + 16 * i; const size_t o = (size_t)(mbase + row) * DM + n;
      const h16x8 oa = *(const h16x8*)(T0 + row * 128 + c8), ob = *(const h16x8*)(T1 + row * 128 + c8);
      const h16x8 ga = *(const h16x8*)(MG + o), gb = *(const h16x8*)(G2 + o);
      *(h16x8*)(MG + o) = ga * oa + gb * ob;
    }
    __syncthreads();
  }
}

FI void phase5(const Params& p, char* lds) {
  const int tid = threadIdx.x, lane = tid & 63, wave = tid >> 6, wr = wave >> 1, wc = wave & 1;
  const h16* MG = (const h16*)(p.ws + WS_B);
  const h16* WO = (const h16*)(p.ws + WS_WO);
  float* X1 = (float*)(p.ws + WS_A);
  for (int it = blockIdx.x; it < 8 * NMT; it += gridDim.x) {
    const int j = it / NMT, mt = it - j * NMT;
    const int mbase = mt * 128, n0 = j * 128;
    f32x4 acc[4][4];
    zero_acc(acc);
    mainloop(acc, MG, DM, mbase, WO + (size_t)n0 * DM, DM, DM, lds);
    stage_acc(acc, (float*)lds);
    __syncthreads();
    {
      const float* T = (const float*)lds;
      const int c8 = (tid & 15) * 8, r0 = tid >> 4, n = n0 + c8;
#pragma unroll 1
      for (int i = 0; i < 8; ++i) {
        const int row = r0 + 16 * i, m = mbase + row;
        const F8 a = ld32(T + row * 128 + c8), x = ld32(xrow(p, m) + n);
        F8 o; o.a = x.a + a.a; o.b = x.b + a.b;
        st32(X1 + (size_t)m * DM + n, o);
      }
    }
    __syncthreads();
  }
}

FI void phase7(const Params& p, char* lds) {
  const int tid = threadIdx.x;
  const h16* XN2 = (const h16*)(p.ws + WS_D);
  const h16* WUP = (const h16*)(p.ws + WS_WUP);
  h16* HH = (h16*)(p.ws + WS_B);
  h16* TG = (h16*)lds; h16* TV = TG + 16384;
  const int c8 = (tid & 15) * 8, r0 = tid >> 4;
  for (int it = blockIdx.x; it < 22 * NMT_H; it += gridDim.x) {
    const int j = it / NMT_H, mt = it - j * NMT_H;
    const int mbase = mt * 126 - 2, n0 = j * 128;
    {
      f32x4 acc[4][4], acc2[4][4];
      zero_acc(acc); zero_acc(acc2);
      mainloop2(acc, acc2, XN2, DM, mbase, WUP + (size_t)n0 * DM, WUP + (size_t)(DFF + n0) * DM, DM, DM, lds);
      stage16(acc, TG); stage16(acc2, TV);
    }
    __syncthreads();
    const int cgc = n0 + c8, cvc = DFF + n0 + c8;
    const float* cw = p.in[I_CFFN];
    const h16x8 g0 = cvth(ld32(cw + cgc)), g1 = cvth(ld32(cw + 5632 + cgc)), g2 = cvth(ld32(cw + 11264 + cgc));
    const h16x8 v0 = cvth(ld32(cw + cvc)), v1 = cvth(ld32(cw + 5632 + cvc)), v2 = cvth(ld32(cw + 11264 + cvc));
#pragma unroll 1
    for (int i = 0; i < 8; ++i) {
      const int row = r0 + 16 * i, m = mbase + row;
      if (row < 2 || m >= MTOK) continue;
      const Tok k = tokinfo(m);
      const h16x8 gc = *(const h16x8*)(TG + row * 128 + c8), vc = *(const h16x8*)(TV + row * 128 + c8);
      h16x8 gp1, gp2, vp1, vp2;
      const float* st = p.in[I_SFFN] + (size_t)(k.seq - 8) * 11264;
      conv_prev16(TG, row, c8, k, st + cgc, 5632, gp1, gp2);
      conv_prev16(TV, row, c8, k, st + cvc, 5632, vp1, vp2);
      const h16x8 cgh = g0 * gp2 + g1 * gp1 + g2 * gc;
      const h16x8 cvh = v0 * vp2 + v1 * vp1 + v2 * vc;
      const F8 cg_ = cvtf(cgh);
      F8 sl;
      sl.a = f32x4{cg_.a.x * sigm(cg_.a.x), cg_.a.y * sigm(cg_.a.y), cg_.a.z * sigm(cg_.a.z), cg_.a.w * sigm(cg_.a.w)};
      sl.b = f32x4{cg_.b.x * sigm(cg_.b.x), cg_.b.y * sigm(cg_.b.y), cg_.b.z * sigm(cg_.b.z), cg_.b.w * sigm(cg_.b.w)};
      *(h16x8*)(HH + (size_t)m * DFF + n0 + c8) = cvth(sl) * cvh;
      if (k.t >= k.T - 2) {
        float* fo = p.out + O_FFN + (size_t)k.seq * 11264 + (k.t - (k.T - 2)) * 5632;
        st32(fo + cgc, cvtf(gc)); st32(fo + cvc, cvtf(vc));
      }
    }
    __syncthreads();
  }
}

FI void phase8(const Params& p, char* lds) {
  const int tid = threadIdx.x, lane = tid & 63, wave = tid >> 6, wr = wave >> 1, wc = wave & 1;
  const h16* HH = (const h16*)(p.ws + WS_B);
  const h16* WDN = (const h16*)(p.ws + WS_WDN);
  float* X1 = (float*)(p.ws + WS_A);
  for (int it = blockIdx.x; it < 8 * NMT; it += gridDim.x) {
    const int j = it / NMT, mt = it - j * NMT;
    const int mbase = mt * 128, n0 = j * 128;
    f32x4 acc[4][4];
    zero_acc(acc);
    mainloop(acc, HH, DFF, mbase, WDN + (size_t)n0 * DFF, DFF, DFF, lds);
    stage_acc(acc, (float*)lds);
    __syncthreads();
    {
      const float* T = (const float*)lds;
      const int c8 = (tid & 15) * 8, r0 = tid >> 4, n = n0 + c8;
#pragma unroll 1
      for (int i = 0; i < 8; ++i) {
        const int row = r0 + 16 * i, m = mbase + row;
        float* q = X1 + (size_t)m * DM + n;
        const F8 a = ld32(T + row * 128 + c8), x = ld32(q);
        F8 o; o.a = x.a + a.a; o.b = x.b + a.b;
        st32(q, o);
      }
    }
    __syncthreads();
  }
}

constexpr int NPHASE = 11;

#define XB_TMO      128
#define XB_XCNT(j)  (256  + 64 * (j))
#define XB_XSUB(j)  (1280 + 64 * (j))
#define XB_XGEN(j)  (2304 + 64 * (j))
#define XB_TOP      3328
#define XB_TOPGEN   3392
#define XCD_BAR_WORDS 3456
#define XB_SPIN_CAP (1u << 18)
FI unsigned xb_ld(unsigned* p)              { return __hip_atomic_load(p, __ATOMIC_RELAXED, __HIP_MEMORY_SCOPE_AGENT); }
FI unsigned xb_add(unsigned* p, unsigned v) { return __hip_atomic_fetch_add(p, v, __ATOMIC_RELAXED, __HIP_MEMORY_SCOPE_AGENT); }
FI unsigned xb_xcc_id() { return (unsigned)__builtin_amdgcn_s_getreg((3 << 11) | 20) & 0xFu; }
#define XB_SPIN(cond, bar) do { unsigned _sp = 0; while (cond) { __builtin_amdgcn_s_sleep(1); \
    if ((++_sp & 255u) == 0u) { if (xb_ld(&(bar)[XB_TMO])) break; if (_sp > XB_SPIN_CAP) { atomicAdd(&(bar)[XB_TMO], 1u); break; } } } } while (0)
struct XcdBarrier { unsigned* bar; unsigned x; volatile unsigned* st; };
FI XcdBarrier xcd_barrier_post(unsigned* bar, volatile unsigned* st) {
  XcdBarrier b; b.bar = bar; b.x = xb_xcc_id(); b.st = st;
  if (threadIdx.x == 0) (void)xb_add(&bar[XB_XCNT(b.x)], 1u);
  return b;
}
FI void xcd_barrier_complete(unsigned* bar, unsigned x, unsigned& nloc, unsigned& nx) {
  const unsigned G = gridDim.x * gridDim.y * gridDim.z;
  unsigned sum, cnt, mine, sp = 0u;
  for (;;) {
    sum = 0u; cnt = 0u; mine = 0u;
#pragma unroll
    for (unsigned j = 0; j < 16; ++j) { const unsigned c = xb_ld(&bar[XB_XCNT(j)]); sum += c; cnt += (c > 0u) ? 1u : 0u; mine = (j == x) ? c : mine; }
    if (sum == G) break;
    __builtin_amdgcn_s_sleep(1);
    if ((++sp & 255u) == 0u) { if (xb_ld(&bar[XB_TMO])) break; if (sp > XB_SPIN_CAP) { atomicAdd(&bar[XB_TMO], 1u); break; } }
  }
  nloc = mine > 0u ? mine : 1u; nx = cnt > 0u ? cnt : 1u;
}
FI void xcd_barrier(const XcdBarrier& b) {
  asm volatile("s_waitcnt vmcnt(0)" ::: "memory");
  __syncthreads();
  if (threadIdx.x == 0) {
    unsigned* bar = b.bar;
    __builtin_amdgcn_s_waitcnt(0);
    unsigned nloc = b.st[0], nx = b.st[1];
    if (nloc == 0u) { xcd_barrier_complete(bar, b.x, nloc, nx); b.st[0] = nloc; b.st[1] = nx; }
    const unsigned old = xb_add(&bar[XB_XSUB(b.x)], 1u);
    const unsigned gen = old / nloc;
    if (old + 1u == (gen + 1u) * nloc) {
      __builtin_amdgcn_fence(__ATOMIC_RELEASE, "agent");
      asm volatile("s_waitcnt vmcnt(0)" ::: "memory");
      const unsigned og = xb_add(&bar[XB_TOP], 1u);
      const unsigned tg = og / nx;
      if (og + 1u == (tg + 1u) * nx) xb_add(&bar[XB_TOPGEN], 1u);
      else XB_SPIN(xb_ld(&bar[XB_TOPGEN]) == tg, bar);
      __builtin_amdgcn_fence(__ATOMIC_ACQUIRE, "agent");
      xb_add(&bar[XB_XGEN(b.x)], 1u);
      asm volatile("s_waitcnt vmcnt(0)" ::: "memory");
    } else {
      XB_SPIN(xb_ld(&bar[XB_XGEN(b.x)]) == gen, bar);
      __builtin_amdgcn_fence(__ATOMIC_ACQUIRE, "agent");
      asm volatile("s_waitcnt vmcnt(0)" ::: "memory");
    }
  }
  __syncthreads();
}

template <int PH> FI void run_phase(const Params& p, char* lds) {
  if (PH == 0) phase0(p, lds);
  if (PH == 1) phase1(p, lds);
  if (PH == 2) phaseA(p, lds);
  if (PH == 3) phase3(p, lds);
  if (PH == 4) phase3b(p, lds);
  if (PH == 5) phase4(p, lds);
  if (PH == 6) phase5(p, lds);
  if (PH == 7) rms_rows(p, 1, (const float*)(p.ws + WS_A), p.in[I_N2G], (h16*)(p.ws + WS_D), blockIdx.x * 4 + (threadIdx.x >> 6), gridDim.x * 4);
  if (PH == 8) phase7(p, lds);
  if (PH == 9) phase8(p, lds);
  if (PH == 10) rms_rows(p, 2, (const float*)(p.ws + WS_A), p.in[I_FNG], nullptr, blockIdx.x * 4 + (threadIdx.x >> 6), gridDim.x * 4);
}

template <int PH> __global__ void __launch_bounds__(256, 1) mega_one(Params p) {
  __shared__ __attribute__((aligned(16))) char lds[65536];
  run_phase<PH>(p, lds);
}

#if N_LAUNCH_MODE == 1
__global__ void __launch_bounds__(256, 2) mega(Params p) {
  __shared__ __attribute__((aligned(16))) char lds[65536 + 16];
  volatile unsigned* st = (volatile unsigned*)(lds + 65536);
  if (threadIdx.x < 4) st[threadIdx.x] = 0u;
  __syncthreads();
  if (p.ph_lo < 0) cg::this_grid().sync();
  XcdBarrier xb = xcd_barrier_post((unsigned*)(p.ws + WS_END), st);
  run_phase<0>(p, lds); xcd_barrier(xb);
  run_phase<1>(p, lds); xcd_barrier(xb);
  run_phase<2>(p, lds); xcd_barrier(xb);
  run_phase<3>(p, lds); xcd_barrier(xb);
  run_phase<4>(p, lds); xcd_barrier(xb);
  run_phase<5>(p, lds); xcd_barrier(xb);
  run_phase<6>(p, lds); xcd_barrier(xb);
  run_phase<7>(p, lds); xcd_barrier(xb);
  run_phase<8>(p, lds); xcd_barrier(xb);
  run_phase<9>(p, lds); xcd_barrier(xb);
  run_phase<10>(p, lds);
}
#endif

extern "C" void kernel_launch(void* const* d_in, const int* in_sizes, int n_in, void* d_out, int out_size,
                              void* d_ws, size_t ws_size, hipStream_t stream) {
  static int grid = 0;
  if (!grid) {
    int dev = 0, cus = 0, per_cu = 0;
    (void)hipGetDevice(&dev);
    (void)hipDeviceGetAttribute(&cus, hipDeviceAttributeMultiprocessorCount, dev);
#if N_LAUNCH_MODE == 1
    (void)hipOccupancyMaxActiveBlocksPerMultiprocessor(&per_cu, mega, 256, 0);
#else
    per_cu = 2;
#endif
    if (per_cu < 1) per_cu = 1;
    if (per_cu > 2) per_cu = 2;
    grid = cus * per_cu;
    if (ws_size < WS_YS + 1048576) fprintf(stderr, "workspace too small: %zu < %zu\n", ws_size, (size_t)WS_END);
  }
  Params p{};
  for (int i = 0; i < 30; ++i) p.in[i] = (const float*)d_in[i];
  p.out = (float*)d_out;
  p.ws = (char*)d_ws;
#if N_LAUNCH_MODE == 1
  p.ph_lo = 0; p.ph_hi = NPHASE;
  (void)hipMemsetAsync((char*)d_ws + WS_END, 0, XCD_BAR_WORDS * 4, stream);
  void* args[] = {&p};
  hipError_t e = hipLaunchCooperativeKernel((void*)mega, dim3(grid), dim3(256), args, 0, stream);
  if (e != hipSuccess) fprintf(stderr, "cooperative launch failed: %s (grid %d)\n", hipGetErrorString(e), grid);
#else
  p.ph_lo = 0; p.ph_hi = NPHASE;
  hipLaunchKernelGGL(mega_one<0>, dim3(grid), dim3(256), 0, stream, p);
  hipLaunchKernelGGL(mega_one<1>, dim3(grid), dim3(256), 0, stream, p);
  hipLaunchKernelGGL(mega_one<2>, dim3(grid), dim3(256), 0, stream, p);
  hipLaunchKernelGGL(mega_one<3>, dim3(grid), dim3(256), 0, stream, p);
  hipLaunchKernelGGL(mega_one<4>, dim3(grid), dim3(256), 0, stream, p);
  hipLaunchKernelGGL(mega_one<5>, dim3(grid), dim3(256), 0, stream, p);
  hipLaunchKernelGGL(mega_one<6>, dim3(grid), dim3(256), 0, stream, p);
  hipLaunchKernelGGL(mega_one<7>, dim3(grid), dim3(256), 0, stream, p);
  hipLaunchKernelGGL(mega_one<8>, dim3(grid), dim3(256), 0, stream, p);
  hipLaunchKernelGGL(mega_one<9>, dim3(grid), dim3(256), 0, stream, p);
  hipLaunchKernelGGL(mega_one<10>, dim3(grid), dim3(256), 0, stream, p);
#endif
}
```

```cpp
#include <hip/hip_runtime.h>
#include <hip/hip_cooperative_groups.h>
#include <stdint.h>
#include <stdio.h>
namespace cg = cooperative_groups;

#ifndef N_LAUNCH_MODE
#define N_LAUNCH_MODE 1
#endif

typedef _Float16 h16;
typedef _Float16 h16x8 __attribute__((ext_vector_type(8)));
typedef _Float16 h16x4 __attribute__((ext_vector_type(4)));
typedef float f32x16 __attribute__((ext_vector_type(16)));
typedef float f32x4 __attribute__((ext_vector_type(4)));
typedef float f32x2 __attribute__((ext_vector_type(2)));

#define FI __device__ __forceinline__

constexpr int DM = 1024;
constexpr int MTOK = 17024;
constexpr int TPR = 2064;
constexpr int NPTOK = 16512;
constexpr int RWP = 3360;
constexpr int PTOT = 8480;
constexpr int DFF = 2816;
constexpr int LAW = 320;
constexpr int NMT_H = 136;
constexpr int NMT = 133;

constexpr size_t O_YP = 0, O_YS = 16777216, O_WKV = 17301504, O_SH = 26214400, O_SC = 26671360, O_FFN = 26949888;

constexpr size_t WS_WIN = 0;
constexpr size_t WS_WA = 17563648, WS_WB = 19660800, WS_WO = 21757952;
constexpr size_t WS_WUP = 23855104, WS_WDN = 35389440;
constexpr size_t WS_WLD = 41156608, WS_WLA = 41287680, WS_WLG = 41418752;
constexpr size_t WS_B = 41811968;
constexpr size_t WS_A = 146407424;
constexpr size_t WS_C = 181272576;
constexpr size_t WS_D = 216137728;
constexpr size_t WS_E = 251002880;
constexpr size_t WS_END = 261898240;

struct Params {
  const float* in[30];
  float* out;
  char* ws;
  int ph_lo, ph_hi;
};

enum { I_XP = 0, I_XS, I_SWKV, I_SSH, I_SSC, I_SFFN, I_META, I_N1G, I_WIN, I_BG, I_MU, I_W0, I_WDEC, I_A0, I_WAAA,
       I_WGATE, I_KK, I_KA, I_RK, I_LNG, I_LNB, I_WBR, I_WBS, I_CSC, I_WOUT, I_N2G, I_WUP, I_CFFN, I_WDN, I_FNG };

FI float sigm(float x) { return __builtin_amdgcn_rcpf(1.f + __expf(-x)); }
FI float tanh_(float x) { return 1.f - 2.f * __builtin_amdgcn_rcpf(1.f + __expf(2.f * x)); }
FI float wave_sum(float v) {
#pragma unroll
  for (int o = 32; o; o >>= 1) v += __shfl_xor(v, o);
  return v;
}
FI float sum16(float v) {
#pragma unroll
  for (int o = 8; o; o >>= 1) v += __shfl_xor(v, o);
  return v;
}
FI float quad_sum(float v) {
  float t = __builtin_bit_cast(float, __builtin_amdgcn_update_dpp(0, __builtin_bit_cast(int, v), 0xB1, 0xF, 0xF, true));
  v += t;
  t = __builtin_bit_cast(float, __builtin_amdgcn_update_dpp(0, __builtin_bit_cast(int, v), 0x4E, 0xF, 0xF, true));
  return v + t;
}
struct Tok { int seq, t, T; };
FI Tok tokinfo(int m) {
  Tok k;
  if (m < NPTOK) { k.seq = m / TPR; k.t = m - k.seq * TPR; k.T = TPR; }
  else { int mm = m - NPTOK; k.seq = 8 + (mm >> 2); k.t = mm & 3; k.T = 4; }
  return k;
}
FI const float* xrow(const Params& p, int m) {
  if (m < NPTOK) {
    int s = m / TPR, t = m - s * TPR;
    return t < 16 ? p.in[I_META] + t * DM : p.in[I_XP] + ((size_t)s * 2048 + (t - 16)) * DM;
  }
  return p.in[I_XS] + (size_t)(m - NPTOK) * DM;
}

FI int swz(int row, int chunk) { return row * 128 + ((chunk ^ ((row >> 1) & 7)) << 4); }

FI void zero_acc(f32x4 (&acc)[4][4]) {
#pragma unroll
  for (int a = 0; a < 4; ++a)
#pragma unroll
    for (int b = 0; b < 4; ++b) acc[a][b] = f32x4{0.f, 0.f, 0.f, 0.f};
}

FI void mainloop(f32x4 (&acc)[4][4], const h16* __restrict__ A, int lda, int mbase,
                 const h16* __restrict__ BT, int ldb, int K, char* lds) {
  const int tid = threadIdx.x, lane = tid & 63, wave = tid >> 6, wr = wave >> 1, wc = wave & 1;
  uint32_t aoff[4], boff[4];
#pragma unroll
  for (int i = 0; i < 4; ++i) {
    const int row = wave * 32 + i * 8 + (lane >> 3);
    const int chunk = (lane & 7) ^ ((row >> 1) & 7);
    int m = mbase + row; m = m < 0 ? 0 : (m > MTOK - 1 ? MTOK - 1 : m);
    aoff[i] = (uint32_t)m * lda + chunk * 8;
    boff[i] = (uint32_t)row * ldb + chunk * 8;
  }
  const int ldsw = wave * 4096 + lane * 16;
#define ML_ISSUE(KT, BUF) do { _Pragma("unroll") for (int i = 0; i < 4; ++i) { \
    __builtin_amdgcn_global_load_lds((const unsigned*)(A + aoff[i] + (KT) * 64), (unsigned*)(lds + (BUF) * 32768 + ldsw + i * 1024), 16, 0, 0); \
    __builtin_amdgcn_global_load_lds((const unsigned*)(BT + boff[i] + (KT) * 64), (unsigned*)(lds + (BUF) * 32768 + 16384 + ldsw + i * 1024), 16, 0, 0); } } while (0)
  const int nk = K >> 6;
  const int rA0 = wr * 64 + (lane & 15), rB0 = wc * 64 + (lane & 15), hh = lane >> 4;
  ML_ISSUE(0, 0);
  for (int kt = 0; kt < nk; ++kt) {
    const int buf = kt & 1;
    asm volatile("s_waitcnt vmcnt(0)" ::: "memory");
    __syncthreads();
    if (kt + 1 < nk) ML_ISSUE(kt + 1, buf ^ 1);
    const char* la = lds + buf * 32768;
    const char* lb = la + 16384;
#pragma unroll
    for (int ks = 0; ks < 2; ++ks) {
      h16x8 a[4], b[4];
#pragma unroll
      for (int t = 0; t < 4; ++t) {
        a[t] = *(const h16x8*)(la + swz(rA0 + t * 16, ks * 4 + hh));
        b[t] = *(const h16x8*)(lb + swz(rB0 + t * 16, ks * 4 + hh));
      }
#pragma unroll
      for (int ti = 0; ti < 4; ++ti)
#pragma unroll
        for (int tj = 0; tj < 4; ++tj) acc[ti][tj] = __builtin_amdgcn_mfma_f32_16x16x32_f16(a[ti], b[tj], acc[ti][tj], 0, 0, 0);
    }
  }
  __syncthreads();
#undef ML_ISSUE
}

FI int swz32(int row, int chunk) { return row * 64 + ((chunk ^ ((0 - (row >> 2)) & 3)) << 4); }
FI void mainloop2(f32x4 (&acc)[4][4], f32x4 (&acc2)[4][4], const h16* __restrict__ A, int lda, int mbase,
                  const h16* __restrict__ BT1, const h16* __restrict__ BT2, int ldb, int K, char* lds) {
  const int tid = threadIdx.x, lane = tid & 63, wave = tid >> 6, wr = wave >> 1, wc = wave & 1;
  uint32_t aoff[2], boff[2];
#pragma unroll
  for (int i = 0; i < 2; ++i) {
    const int row = wave * 32 + i * 16 + (lane >> 2);
    const int chunk = (lane & 3) ^ ((0 - (row >> 2)) & 3);
    int m = mbase + row; m = m < 0 ? 0 : (m > MTOK - 1 ? MTOK - 1 : m);
    aoff[i] = (uint32_t)m * lda + chunk * 8;
    boff[i] = (uint32_t)row * ldb + chunk * 8;
  }
  const int ldsw = wave * 2048 + lane * 16;
#define ML2_ISSUE(KT, BUF) do { _Pragma("unroll") for (int i = 0; i < 2; ++i) { \
    __builtin_amdgcn_global_load_lds((const unsigned*)(A + aoff[i] + (KT) * 32), (unsigned*)(lds + (BUF) * 24576 + ldsw + i * 1024), 16, 0, 0); \
    __builtin_amdgcn_global_load_lds((const unsigned*)(BT1 + boff[i] + (KT) * 32), (unsigned*)(lds + (BUF) * 24576 + 8192 + ldsw + i * 1024), 16, 0, 0); \
    __builtin_amdgcn_global_load_lds((const unsigned*)(BT2 + boff[i] + (KT) * 32), (unsigned*)(lds + (BUF) * 24576 + 16384 + ldsw + i * 1024), 16, 0, 0); } } while (0)
  const int nk = K >> 5;
  const int rA0 = wr * 64 + (lane & 15), rB0 = wc * 64 + (lane & 15), hh = lane >> 4;
  ML2_ISSUE(0, 0);
  for (int kt = 0; kt < nk; ++kt) {
    const int buf = kt & 1;
    asm volatile("s_waitcnt vmcnt(0)" ::: "memory");
    __syncthreads();
    if (kt + 1 < nk) ML2_ISSUE(kt + 1, buf ^ 1);
    const char* la = lds + buf * 24576;
    const char* lb = la + 8192;
    const char* lc = la + 16384;
    {
      h16x8 a[4], b[4], c[4];
#pragma unroll
      for (int t = 0; t < 4; ++t) {
        a[t] = *(const h16x8*)(la + swz32(rA0 + t * 16, hh));
        b[t] = *(const h16x8*)(lb + swz32(rB0 + t * 16, hh));
        c[t] = *(const h16x8*)(lc + swz32(rB0 + t * 16, hh));
      }
#pragma unroll
      for (int ti = 0; ti < 4; ++ti)
#pragma unroll
        for (int tj = 0; tj < 4; ++tj) {
          acc[ti][tj] = __builtin_amdgcn_mfma_f32_16x16x32_f16(a[ti], b[tj], acc[ti][tj], 0, 0, 0);
          acc2[ti][tj] = __builtin_amdgcn_mfma_f32_16x16x32_f16(a[ti], c[tj], acc2[ti][tj], 0, 0, 0);
        }
    }
  }
  __syncthreads();
#undef ML2_ISSUE
}

#define CROW(ti, reg) (wr * 64 + (ti) * 16 + 4 * (lane >> 4) + (reg))
#define CCOL(tj) (wc * 64 + (tj) * 16 + (lane & 15))

FI void stage_acc(const f32x4 (&acc)[4][4], float* T) {
  const int tid = threadIdx.x, lane = tid & 63, wave = tid >> 6, wr = wave >> 1, wc = wave & 1;
#pragma unroll
  for (int ti = 0; ti < 4; ++ti)
#pragma unroll
    for (int tj = 0; tj < 4; ++tj)
#pragma unroll
      for (int r = 0; r < 4; ++r) T[CROW(ti, r) * 128 + CCOL(tj)] = acc[ti][tj][r];
}

FI int win_map(int dr) {
  if (dr < 3360) return dr;
  if (dr < 3456) return -1;
  if (dr < 4480) return 3360 + (dr - 3456);
  if (dr < 5504) return 5408 + (dr - 4480);
  if (dr < 6528) return 4384 + (dr - 5504);
  return 6432 + (dr - 6528);
}
FI void transpose_tile(const float* __restrict__ src, int ldsrc, int Ksrc, int Nsrc, int mode, int rt, int ktile,
                       h16* __restrict__ dst, int lddst, float* sm) {
  const int tid = threadIdx.x;
  {
    const int rr = tid & 63, kq = tid >> 6;
    const int dr = rt * 64 + rr;
    int col = mode ? win_map(dr) : (dr < Nsrc ? dr : -1);
#pragma unroll
    for (int i = 0; i < 16; ++i) {
      int kk = kq + 4 * i, k = ktile * 64 + kk;
      float v = (col >= 0 && k < Ksrc) ? src[(size_t)k * ldsrc + col] : 0.f;
      sm[kk * 65 + rr] = v;
    }
  }
  __syncthreads();
  {
    const int dr = tid >> 2, seg = tid & 3;
    h16x8 o0, o1;
#pragma unroll
    for (int j = 0; j < 8; ++j) { o0[j] = (h16)sm[(seg * 16 + j) * 65 + dr]; o1[j] = (h16)sm[(seg * 16 + 8 + j) * 65 + dr]; }
    h16* d = dst + (size_t)(rt * 64 + dr) * lddst + ktile * 64 + seg * 16;
    *(h16x8*)d = o0; *(h16x8*)(d + 8) = o1;
  }
  __syncthreads();
}

FI void rms_rows(const Params& p, int mode, const float* __restrict__ src, const float* __restrict__ g, h16* dsth, int gw, int nw) {
  const int lane = threadIdx.x & 63;
  for (int m = gw; m < MTOK; m += nw) {
    f32x4 v[4]; float ss = 0.f;
    if (mode == 0) {
      const float* row = xrow(p, m);
#pragma unroll
      for (int i = 0; i < 4; ++i) v[i] = *(const f32x4*)(row + lane * 4 + 256 * i);
    } else {
      const h16* row = (const h16*)src + (size_t)m * DM;
#pragma unroll
      for (int i = 0; i < 4; ++i) { const h16x4 h = *(const h16x4*)(row + lane * 4 + 256 * i); v[i] = f32x4{(float)h[0], (float)h[1], (float)h[2], (float)h[3]}; }
    }
#pragma unroll
    for (int i = 0; i < 4; ++i) ss += v[i].x * v[i].x + v[i].y * v[i].y + v[i].z * v[i].z + v[i].w * v[i].w;
    ss = wave_sum(ss);
    const float rs = rsqrtf(ss * (1.f / DM) + 1e-6f);
    if (mode == 2) {
      float* o;
      if (m < NPTOK) { int s = m / TPR, t = m - s * TPR; if (t < 16) continue; o = p.out + O_YP + ((size_t)s * 2048 + (t - 16)) * DM; }
      else o = p.out + O_YS + (size_t)(m - NPTOK) * DM;
#pragma unroll
      for (int i = 0; i < 4; ++i) { f32x4 gg = *(const f32x4*)(g + lane * 4 + 256 * i); f32x4 r = v[i] * rs * gg; *(f32x4*)(o + lane * 4 + 256 * i) = r; }
    } else {
#pragma unroll
      for (int i = 0; i < 4; ++i) {
        f32x4 gg = *(const f32x4*)(g + lane * 4 + 256 * i); f32x4 r = v[i] * rs * gg;
        h16x4 h; h[0] = (h16)r.x; h[1] = (h16)r.y; h[2] = (h16)r.z; h[3] = (h16)r.w;
        *(h16x4*)(dsth + (size_t)m * DM + lane * 4 + 256 * i) = h;
      }
    }
  }
}

FI void transpose_item(const Params& p, float* sm, int it) {
  {
    int i = it;
    if (i < 2144) { transpose_tile(p.in[I_WIN], PTOT, 1024, PTOT, 1, i >> 4, i & 15, (h16*)(p.ws + WS_WIN), 1024, sm); return; }
    i -= 2144;
    if (i < 256) { transpose_tile(p.in[I_WBR], 1024, 1024, 1024, 0, i >> 4, i & 15, (h16*)(p.ws + WS_WA), 1024, sm); return; }
    i -= 256;
    if (i < 256) { transpose_tile(p.in[I_WBS], 1024, 1024, 1024, 0, i >> 4, i & 15, (h16*)(p.ws + WS_WB), 1024, sm); return; }
    i -= 256;
    if (i < 256) { transpose_tile(p.in[I_WOUT], 1024, 1024, 1024, 0, i >> 4, i & 15, (h16*)(p.ws + WS_WO), 1024, sm); return; }
    i -= 256;
    if (i < 1408) { transpose_tile(p.in[I_WUP], 5632, 1024, 5632, 0, i >> 4, i & 15, (h16*)(p.ws + WS_WUP), 1024, sm); return; }
    i -= 1408;
    if (i < 704) { transpose_tile(p.in[I_WDN], 1024, 2816, 1024, 0, i / 44, i % 44, (h16*)(p.ws + WS_WDN), 2816, sm); return; }
    i -= 704;
    if (i < 16) { transpose_tile(p.in[I_WDEC], 1024, 64, 1024, 0, i, 0, (h16*)(p.ws + WS_WLD), 64, sm); return; }
    i -= 16;
    if (i < 16) { transpose_tile(p.in[I_WAAA], 1024, 64, 1024, 0, i, 0, (h16*)(p.ws + WS_WLA), 64, sm); return; }
    i -= 16;
    transpose_tile(p.in[I_WGATE], 1024, 160, 1024, 0, i / 3, i % 3, (h16*)(p.ws + WS_WLG), 192, sm);
  }
}

FI void phase0(const Params& p, char* lds) {
  float* sm = (float*)lds;
  h16* ws = (h16*)p.ws;
  for (int it = blockIdx.x; it < 2144 + 80; it += gridDim.x) transpose_item(p, sm, it < 2144 ? it : it + 2880);
  (void)ws;
  rms_rows(p, 0, nullptr, p.in[I_N1G], (h16*)(p.ws + WS_A), blockIdx.x * 4 + (threadIdx.x >> 6), gridDim.x * 4);
}

struct F8 { f32x4 a, b; };
FI F8 ld16(const h16* q) { h16x8 v = *(const h16x8*)q; F8 r; r.a = f32x4{(float)v[0], (float)v[1], (float)v[2], (float)v[3]}; r.b = f32x4{(float)v[4], (float)v[5], (float)v[6], (float)v[7]}; return r; }
FI F8 ld32(const float* q) { F8 r; r.a = *(const f32x4*)q; r.b = *(const f32x4*)(q + 4); return r; }
FI F8 zero8() { F8 r; r.a = f32x4{0.f, 0.f, 0.f, 0.f}; r.b = r.a; return r; }
FI void st16(h16* q, const F8& v) { h16x8 h; h[0] = (h16)v.a.x; h[1] = (h16)v.a.y; h[2] = (h16)v.a.z; h[3] = (h16)v.a.w; h[4] = (h16)v.b.x; h[5] = (h16)v.b.y; h[6] = (h16)v.b.z; h[7] = (h16)v.b.w; *(h16x8*)q = h; }
FI void st32(float* q, const F8& v) { *(f32x4*)q = v.a; *(f32x4*)(q + 4) = v.b; }
FI void stage16(const f32x4 (&acc)[4][4], h16* T) {
  const int tid = threadIdx.x, lane = tid & 63, wave = tid >> 6, wr = wave >> 1, wc = wave & 1;
#pragma unroll
  for (int ti = 0; ti < 4; ++ti)
#pragma unroll
    for (int tj = 0; tj < 4; ++tj)
#pragma unroll
      for (int r = 0; r < 4; ++r) T[CROW(ti, r) * 128 + CCOL(tj)] = (h16)acc[ti][tj][r];
}
typedef _Float16 h16x2 __attribute__((ext_vector_type(2)));
FI void pack_acc(const f32x4 (&acc)[4][4], uint32_t (&pk)[4][4][2]) {
#pragma unroll
  for (int ti = 0; ti < 4; ++ti)
#pragma unroll
    for (int tj = 0; tj < 4; ++tj)
#pragma unroll
      for (int r = 0; r < 4; r += 2) {
        h16x2 h2; h2[0] = (h16)acc[ti][tj][r]; h2[1] = (h16)acc[ti][tj][r + 1];
        pk[ti][tj][r >> 1] = __builtin_bit_cast(uint32_t, h2);
      }
}
FI void stage16_pk(const uint32_t (&pk)[4][4][2], h16* T) {
  const int tid = threadIdx.x, lane = tid & 63, wave = tid >> 6, wr = wave >> 1, wc = wave & 1;
#pragma unroll
  for (int ti = 0; ti < 4; ++ti)
#pragma unroll
    for (int tj = 0; tj < 4; ++tj)
#pragma unroll
      for (int r = 0; r < 4; r += 2) {
        h16x2 h2 = __builtin_bit_cast(h16x2, pk[ti][tj][r >> 1]);
        T[CROW(ti, r) * 128 + CCOL(tj)] = h2[0];
        T[CROW(ti, r + 1) * 128 + CCOL(tj)] = h2[1];
      }
}
FI void conv_prev(const h16* T, int row, int c8, const Tok& k, const float* st  , int ld, F8& p1, F8& p2) {
  if (k.t >= 2) { p1 = ld16(T + (row - 1) * 128 + c8); p2 = ld16(T + (row - 2) * 128 + c8); }
  else if (k.t == 1) { p1 = ld16(T + (row - 1) * 128 + c8); p2 = k.seq >= 8 ? ld32(st + ld) : zero8(); }
  else { if (k.seq >= 8) { p1 = ld32(st + ld); p2 = ld32(st); } else { p1 = zero8(); p2 = zero8(); } }
}

FI h16x8 cvth(const F8& v) { h16x8 h; h[0] = (h16)v.a.x; h[1] = (h16)v.a.y; h[2] = (h16)v.a.z; h[3] = (h16)v.a.w; h[4] = (h16)v.b.x; h[5] = (h16)v.b.y; h[6] = (h16)v.b.z; h[7] = (h16)v.b.w; return h; }
FI F8 cvtf(const h16x8& v) { F8 r; r.a = f32x4{(float)v[0], (float)v[1], (float)v[2], (float)v[3]}; r.b = f32x4{(float)v[4], (float)v[5], (float)v[6], (float)v[7]}; return r; }
FI h16x8 zeroh() { h16x8 h; for (int i = 0; i < 8; ++i) h[i] = (h16)0.f; return h; }
FI void conv_prev16(const h16* T, int row, int c8, const Tok& k, const float* st  , int ld, h16x8& p1, h16x8& p2) {
  if (k.t >= 2) { p1 = *(const h16x8*)(T + (row - 1) * 128 + c8); p2 = *(const h16x8*)(T + (row - 2) * 128 + c8); }
  else if (k.t == 1) { p1 = *(const h16x8*)(T + (row - 1) * 128 + c8); p2 = k.seq >= 8 ? cvth(ld32(st + ld)) : zeroh(); }
  else { if (k.seq >= 8) { p1 = cvth(ld32(st + ld)); p2 = cvth(ld32(st)); } else { p1 = zeroh(); p2 = zeroh(); } }
}

FI void phase1(const Params& p, char* lds) {
  const int tid = threadIdx.x;
  const h16* XN = (const h16*)(p.ws + WS_A);
  const h16* WinT = (const h16*)(p.ws + WS_WIN);
  h16* PB = (h16*)(p.ws + WS_B);
  h16* ZB = (h16*)(p.ws + WS_C);
  h16* LA = (h16*)(p.ws + WS_E);
  const int c8 = (tid & 15) * 8, r0 = tid >> 4;
  for (int it = blockIdx.x; it < 35 * NMT_H; it += gridDim.x) {
    const int j = it / NMT_H, mt = it - j * NMT_H;
    const int mbase = mt * 126 - 2;
    {
      const int npass = j < 8 ? 3 : 1;
      uint32_t pk[4][4][2];
#pragma unroll 1
      for (int pass = 0; pass < npass; ++pass) {
        int brow;
        if (j < 8) brow = (pass == 0 ? 3456 : (pass == 1 ? 4480 : 5504)) + j * 128;
        else brow = (j - 8) * 128;
        f32x4 acc[4][4];
        zero_acc(acc);
        mainloop(acc, XN, DM, mbase, WinT + (size_t)brow * DM, DM, DM, lds);
        if (j < 8) {
          if (pass == 0) pack_acc(acc, pk);
          else if (pass == 1) {
#pragma unroll
            for (int ti = 0; ti < 4; ++ti)
#pragma unroll
              for (int tj = 0; tj < 4; ++tj)
#pragma unroll
                for (int r = 0; r < 4; r += 2) {
                  h16x2 h2 = __builtin_bit_cast(h16x2, pk[ti][tj][r >> 1]);
                  h2[0] = (h16)((float)h2[0] * acc[ti][tj][r]); h2[1] = (h16)((float)h2[1] * acc[ti][tj][r + 1]);
                  pk[ti][tj][r >> 1] = __builtin_bit_cast(uint32_t, h2);
                }
          } else { stage16_pk(pk, (h16*)lds); stage16(acc, (h16*)lds + 16384); }
        } else stage_acc(acc, (float*)lds);
      }
    }
    if (j < 8) {
      const int n0 = j * 128;
      h16* TU = (h16*)lds; h16* TB = TU + 16384;
      __syncthreads();
      const int ch = n0 + c8;
      const float* cw = p.in[I_CSC];
      const h16x8 w0 = cvth(ld32(cw + ch)), w1 = cvth(ld32(cw + 1024 + ch)), w2 = cvth(ld32(cw + 2048 + ch));
#pragma unroll 1
      for (int i = 0; i < 8; ++i) {
        const int row = r0 + 16 * i, m = mbase + row;
        if (row < 2 || m >= MTOK) continue;
        const Tok k = tokinfo(m);
        const h16x8 cur = *(const h16x8*)(TU + row * 128 + c8), bg = *(const h16x8*)(TB + row * 128 + c8);
        h16x8 p1, p2;
        conv_prev16(TU, row, c8, k, p.in[I_SSC] + (size_t)(k.seq - 8) * 2048 + ch, 1024, p1, p2);
        *(h16x8*)(ZB + (size_t)m * DM + ch) = bg * (w0 * p2 + w1 * p1 + w2 * cur);
        if (k.t >= k.T - 2) st32(p.out + O_SC + (size_t)k.seq * 2048 + (k.t - (k.T - 2)) * 1024 + ch, cvtf(cur));
      }
      __syncthreads();
    } else {
      const int n0 = (j - 8) * 128;
      float* T = (float*)lds;
      __syncthreads();
      const int n = n0 + c8;
      const F8 muv = n < RWP ? ld32(p.in[I_MU] + n) : zero8();
#pragma unroll 1
      for (int i = 0; i < 8; ++i) {
        const int row = r0 + 16 * i, m = mbase + row;
        if (row < 2 || m >= MTOK) continue;
        const Tok k = tokinfo(m);
        const F8 cur = ld32(T + row * 128 + c8);
        F8 prev;
        if (k.t >= 1) prev = ld32(T + (row - 1) * 128 + c8);
        else prev = (k.seq >= 8 && n < RWP) ? ld32(p.in[I_SSH] + (size_t)(k.seq - 8) * RWP + n) : zero8();
        F8 xs;
        xs.a = cur.a + (prev.a - cur.a) * muv.a;
        xs.b = cur.b + (prev.b - cur.b) * muv.b;
        if (n < 3072) st16(PB + (size_t)m * 3072 + n, xs);
        else {
          const int q = n - 3072;
          if (q < LAW) {
            F8 v;
            if (q < 64) { v.a = f32x4{tanh_(xs.a.x), tanh_(xs.a.y), tanh_(xs.a.z), tanh_(xs.a.w)}; v.b = f32x4{tanh_(xs.b.x), tanh_(xs.b.y), tanh_(xs.b.z), tanh_(xs.b.w)}; }
            else if (q < 128) v = xs;
            else if (q < 288) { v.a = f32x4{sigm(xs.a.x), sigm(xs.a.y), sigm(xs.a.z), sigm(xs.a.w)}; v.b = f32x4{sigm(xs.b.x), sigm(xs.b.y), sigm(xs.b.z), sigm(xs.b.w)}; }
            else v = zero8();
            st16(LA + (size_t)m * LAW + q, v);
          }
        }
        if (n < RWP && k.t == k.T - 1) st32(p.out + O_SH + (size_t)k.seq * RWP + n, cur);
      }
      __syncthreads();
    }
  }
}

template <int CTRL> FI float dpp_mov(float v) { return __builtin_bit_cast(float, __builtin_amdgcn_update_dpp(0, __builtin_bit_cast(int, v), CTRL, 0xF, 0xF, true)); }
FI float row8_sum(float v) { v += dpp_mov<0xB1>(v); v += dpp_mov<0x4E>(v); v += dpp_mov<0x141>(v); return v; }
FI float row16_sum(float v) { v = row8_sum(v); v += dpp_mov<0x140>(v); return v; }

constexpr size_t OUT_Y_BYTES = 34865152;
constexpr size_t WS_YS = WS_END + 65536;
FI h16* yrow(const Params& p, int m) {
  return m < NPTOK ? (h16*)((char*)p.out + OUT_Y_BYTES) + (size_t)m * DM : (h16*)(p.ws + WS_YS) + (size_t)(m - NPTOK) * DM;
}

FI void phaseA(const Params& p, char* lds) {
  const int tid = threadIdx.x, lane = tid & 63, wave = tid >> 6, wr = wave >> 1, wc = wave & 1;
  const h16* LA = (const h16*)(p.ws + WS_E);
  h16* DA = (h16*)p.out;
  h16* AA = (h16*)(p.ws + WS_D);
  for (int it = blockIdx.x; it < 16 * NMT; it += gridDim.x) {
    const int j = it / NMT, mt = it - j * NMT;
    const int mbase = mt * 128, which = j >> 3, n0 = (j & 7) * 128;
    f32x4 acc[4][4];
    zero_acc(acc);
    if (which == 0) mainloop(acc, LA, LAW, mbase, (const h16*)(p.ws + WS_WLD) + (size_t)n0 * 64, 64, 64, lds);
    else mainloop(acc, LA + 64, LAW, mbase, (const h16*)(p.ws + WS_WLA) + (size_t)n0 * 64, 64, 64, lds);
    h16* dst = which == 0 ? DA : AA;
    stage_acc(acc, (float*)lds);
    __syncthreads();
    if (which == 0) {
      const float* T = (const float*)lds;
      const int ci = tid >> 5, cq = (tid & 31) * 4, n = n0 + cq;
      const f32x4 bias = *(const f32x4*)(p.in[I_W0] + n);
      f32x4 run = {1.f, 1.f, 1.f, 1.f};
#pragma unroll 1
      for (int rr = 0; rr < 16; ++rr) {
        const int row = ci * 16 + rr, m = mbase + row;
        if (m >= NPTOK && (m & 3) == 0) run = f32x4{1.f, 1.f, 1.f, 1.f};
        const f32x4 x = *(const f32x4*)(T + row * 128 + cq) + bias;
        run = run * f32x4{__expf(-0.60653066f * sigm(x.x)), __expf(-0.60653066f * sigm(x.y)), __expf(-0.60653066f * sigm(x.z)), __expf(-0.60653066f * sigm(x.w))};
        h16x4 h; h[0] = (h16)run.x; h[1] = (h16)run.y; h[2] = (h16)run.z; h[3] = (h16)run.w;
        *(h16x4*)(dst + (size_t)m * DM + n) = h;
      }
    } else {
      const float* T = (const float*)lds;
      const int c8 = (tid & 15) * 8, r0 = tid >> 4, n = n0 + c8;
      const float* w0p = p.in[I_W0]; const float* a0p = p.in[I_A0];
      const F8 bias = ld32((which == 0 ? w0p : a0p) + n);
#pragma unroll 1
      for (int i = 0; i < 8; ++i) {
        const int row = r0 + 16 * i, m = mbase + row;
        const F8 a = ld32(T + row * 128 + c8);
        const f32x4 xa = a.a + bias.a, xb = a.b + bias.b;
        F8 o;
        o.a = f32x4{sigm(xa.x), sigm(xa.y), sigm(xa.z), sigm(xa.w)}; o.b = f32x4{sigm(xb.x), sigm(xb.y), sigm(xb.z), sigm(xb.w)};
        if (which == 0) {
          o.a = f32x4{__expf(-0.60653066f * o.a.x), __expf(-0.60653066f * o.a.y), __expf(-0.60653066f * o.a.z), __expf(-0.60653066f * o.a.w)};
          o.b = f32x4{__expf(-0.60653066f * o.b.x), __expf(-0.60653066f * o.b.y), __expf(-0.60653066f * o.b.z), __expf(-0.60653066f * o.b.w)};
        }
        st16(dst + (size_t)m * DM + n, o);
      }
    }
    __syncthreads();
  }
}

FI void scan_unit(const Params& p, float* sm, int seq, int head, int half) {
  const int tid = threadIdx.x;
  const int T = seq < 8 ? TPR : 4;
  const int mseq = seq < 8 ? seq * TPR : NPTOK + (seq - 8) * 4;
  const h16* PB = (const h16*)(p.ws + WS_B);
  const h16* DA = (const h16*)p.out;
  const h16* AA = (const h16*)(p.ws + WS_D);
  const int rp = tid >> 4, cb = tid & 15;
  const int chp = head * 64 + cb * 4;
  const int row0 = half * 32 + rp * 2;
  f32x2 S0a, S0b, S1a, S1b;
  if (seq >= 8) {
    const float* sp = p.in[I_SWKV] + ((size_t)(seq - 8) * 16 + head) * 4096 + row0 * 64 + cb * 4;
    const f32x4 u = *(const f32x4*)sp, w = *(const f32x4*)(sp + 64);
    S0a = f32x2{u.x, u.y}; S0b = f32x2{u.z, u.w}; S1a = f32x2{w.x, w.y}; S1b = f32x2{w.z, w.w};
  } else { S0a = f32x2{0.f, 0.f}; S0b = S0a; S1a = S0a; S1b = S0a; }
  const f32x4 kkc = *(const f32x4*)(p.in[I_KK] + chp), kac = *(const f32x4*)(p.in[I_KA] + chp);
  const int nch = (T + 15) >> 4;
  h16x2* YP = (h16x2*)(sm + 12288);
  h16x4 Apr, Apk, Apv, Apd, Apa, Ape, Bpr, Bpk, Bpv, Bpd, Bpa, Bpe, Cpr, Cpk, Cpv, Cpd, Cpa, Cpe;
#define SC_LOAD(P, T0) do { int mp = (T0) + rp; if (mp > T - 1) mp = T - 1; const size_t mm = (size_t)(mseq + mp); \
    const h16* pp = PB + mm * 3072 + chp; P##pr = *(const h16x4*)pp; P##pk = *(const h16x4*)(pp + 1024); P##pv = *(const h16x4*)(pp + 2048); \
    P##pd = *(const h16x4*)(DA + mm * DM + chp); P##pa = *(const h16x4*)(AA + mm * DM + chp); \
    P##pe = *(const h16x4*)(DA + (mm - (rp > 0 ? 1 : 0)) * DM + chp); } while (0)
#define SC_PREP(P, BUF) do { float* bb = sm + (BUF) * 6144; \
    const f32x4 r4 = {(float)P##pr[0], (float)P##pr[1], (float)P##pr[2], (float)P##pr[3]}; \
    const f32x4 k4 = {(float)P##pk[0], (float)P##pk[1], (float)P##pk[2], (float)P##pk[3]}; \
    const f32x4 v4 = {(float)P##pv[0], (float)P##pv[1], (float)P##pv[2], (float)P##pv[3]}; \
    const f32x4 lam = {(float)P##pd[0], (float)P##pd[1], (float)P##pd[2], (float)P##pd[3]}; \
    f32x4 lam1 = {(float)P##pe[0], (float)P##pe[1], (float)P##pe[2], (float)P##pe[3]}; \
    if (rp == 0) lam1 = f32x4{1.f, 1.f, 1.f, 1.f}; \
    const f32x4 linv = f32x4{__builtin_amdgcn_rcpf(lam.x), __builtin_amdgcn_rcpf(lam.y), __builtin_amdgcn_rcpf(lam.z), __builtin_amdgcn_rcpf(lam.w)}; \
    const f32x4 a4 = {(float)P##pa[0], (float)P##pa[1], (float)P##pa[2], (float)P##pa[3]}; \
    const f32x4 kkv = k4 * kkc; \
    const float ss = row16_sum(kkv.x * kkv.x + kkv.y * kkv.y + kkv.z * kkv.z + kkv.w * kkv.w); \
    const f32x4 kk = kkv * __builtin_amdgcn_rcpf(fmaxf(__builtin_amdgcn_sqrtf(ss), 1e-12f)); \
    const int o = rp * 64 + cb * 4; \
      \
    *(f32x4*)(bb + o) = r4 * lam; *(f32x4*)(bb + 1024 + o) = lam; *(f32x4*)(bb + 2048 + o) = k4 * (1.f + (a4 - 1.f) * kac) * linv; \
    *(f32x4*)(bb + 3072 + o) = v4; *(f32x4*)(bb + 4096 + o) = -kk * lam1; *(f32x4*)(bb + 5120 + o) = kk * a4 * linv; } while (0)
#define ST_LOAD(X, TT) do { const float* q_ = bb + (TT) * 64 + cb * 4; \
    X##a = *(const f32x4*)(q_ + 4096); X##b = *(const f32x4*)(q_ + 5120); \
    X##k = *(const f32x4*)(q_ + 2048); X##r = *(const f32x4*)q_; X##v = *(const f32x2*)(bb + 3072 + (TT) * 64 + row0); } while (0)
#define LO(v) f32x2{(v).x, (v).y}
#define HI(v) f32x2{(v).z, (v).w}
#define ST_COMP(X, TT) do { \
    f32x2 s0_ = S0a * LO(X##a), s1_ = S1a * LO(X##a); s0_ = S0b * HI(X##a) + s0_; s1_ = S1b * HI(X##a) + s1_; \
    const f32x2 v0_ = {X##v.x, X##v.x}, v1_ = {X##v.y, X##v.y}; \
    const f32x2 u0a_ = LO(X##k) * v0_ + S0a, u0b_ = HI(X##k) * v0_ + S0b; \
    const f32x2 u1a_ = LO(X##k) * v1_ + S1a, u1b_ = HI(X##k) * v1_ + S1b; \
    const float sa0_ = row16_sum(s0_.x + s0_.y), sa1_ = row16_sum(s1_.x + s1_.y); \
    const f32x2 q0_ = {sa0_, sa0_}, q1_ = {sa1_, sa1_}; \
    S0a = LO(X##b) * q0_ + u0a_; S0b = HI(X##b) * q0_ + u0b_; S1a = LO(X##b) * q1_ + u1a_; S1b = HI(X##b) * q1_ + u1b_; \
    f32x2 y0_ = S0a * LO(X##r), y1_ = S1a * LO(X##r); y0_ = S0b * HI(X##r) + y0_; y1_ = S1b * HI(X##r) + y1_; \
    { h16x2 yp_; yp_[0] = (h16)(y0_.x + y0_.y); yp_[1] = (h16)(y1_.x + y1_.y); YP[(TT) * 256 + tid] = yp_; } } while (0)
#define SC_BODY(c, LSET, PSET) do { \
    const int t0 = (c) * 16; \
    const int nt = (T - t0) < 16 ? (T - t0) : 16;       \
    const float* bb = sm + ((c) & 1) * 6144; \
    if ((c) + 3 < nch) SC_LOAD(LSET, t0 + 48); \
    { \
      f32x4 Aa, Ab, Ak, Ar; f32x2 Av; \
      f32x4 Ba, Bb, Bk, Br; f32x2 Bv; \
      ST_LOAD(A, 0); \
      for (int tt = 0; tt < nt; tt += 2) { \
        ST_LOAD(B, tt + 1); \
        ST_COMP(A, tt); \
        const int tn = tt + 2 < nt ? tt + 2 : tt; \
        ST_LOAD(A, tn); \
        ST_COMP(B, tt + 1); \
      } \
    } \
    {   \
      const f32x4 ll_ = *(const f32x4*)(bb + 1024 + (nt - 1) * 64 + cb * 4); \
      S0a = S0a * LO(ll_); S0b = S0b * HI(ll_); S1a = S1a * LO(ll_); S1b = S1b * HI(ll_); } \
    __syncthreads(); \
    if (rp < nt) {     \
      const uint4* q_ = (const uint4*)(YP + rp * 256 + cb * 16); \
      float a0_ = 0.f, a1_ = 0.f; \
      _Pragma("unroll") for (int e_ = 0; e_ < 4; ++e_) { \
        const uint4 w_ = q_[e_]; \
        const h16x2 p0_ = __builtin_bit_cast(h16x2, w_.x), p1_ = __builtin_bit_cast(h16x2, w_.y), p2_ = __builtin_bit_cast(h16x2, w_.z), p3_ = __builtin_bit_cast(h16x2, w_.w); \
        a0_ += ((float)p0_[0] + (float)p1_[0]) + ((float)p2_[0] + (float)p3_[0]); \
        a1_ += ((float)p0_[1] + (float)p1_[1]) + ((float)p2_[1] + (float)p3_[1]); \
      } \
      h16x2 yh; yh[0] = (h16)a0_; yh[1] = (h16)a1_; \
      *(h16x2*)(yrow(p, mseq + t0 + rp) + head * 64 + half * 32 + cb * 2) = yh; \
    } \
    if ((c) + 1 < nch) SC_PREP(PSET, ((c) + 1) & 1);     \
    __syncthreads(); } while (0)
  SC_LOAD(A, 0);
  if (nch > 1) { SC_LOAD(B, 16); SC_LOAD(C, 32); }
  SC_PREP(A, 0);
  __syncthreads();
  for (int c = 0; c < nch; c += 3) {
    SC_BODY(c, A, B);
    if (c + 1 < nch) SC_BODY(c + 1, B, C);
    if (c + 2 < nch) SC_BODY(c + 2, C, A);
  }
#undef SC_BODY
  {
    float* op = p.out + O_WKV + ((size_t)seq * 16 + head) * 4096 + row0 * 64 + cb * 4;
    *(f32x4*)op = f32x4{S0a.x, S0a.y, S0b.x, S0b.y}; *(f32x4*)(op + 64) = f32x4{S1a.x, S1a.y, S1b.x, S1b.y};
  }
  __syncthreads();
#undef SC_LOAD
#undef SC_PREP
#undef ST_LOAD
#undef ST_COMP
#undef LO
#undef HI
}

FI void phase3(const Params& p, char* lds) {
  float* sm = (float*)lds;
  const int G = gridDim.x, b = blockIdx.x;
  for (int u = b; u < 256; u += G) scan_unit(p, sm, u >> 5, (u >> 1) & 15, u & 1);
  if (G > 256) {
    if (b >= 256) {
      for (int u = b - 256; u < 4096; u += G - 256) scan_unit(p, sm, 8 + (u >> 5), (u >> 1) & 15, u & 1);
      for (int it = 2144 + (b - 256); it < 5024; it += G - 256) transpose_item(p, sm, it);
    }
  }
  else {
    for (int u = b; u < 4096; u += G) scan_unit(p, sm, 8 + (u >> 5), (u >> 1) & 15, u & 1);
    for (int it = 2144 + b; it < 5024; it += G) transpose_item(p, sm, it);
  }
}

FI void phase3b(const Params& p, char* lds) {
  const int tid = threadIdx.x;
  const h16* LA = (const h16*)(p.ws + WS_E);
  const h16* PB = (const h16*)(p.ws + WS_B);
  h16* AZ = (h16*)(p.ws + WS_D);
  h16* TG = (h16*)lds;
  const int c8 = (tid & 15) * 8, r0 = tid >> 4;
  for (int it = blockIdx.x; it < 8 * NMT; it += gridDim.x) {
    const int j = it / NMT, mt = it - j * NMT;
    const int mbase = mt * 128, n0 = j * 128;
    {
      f32x4 acc[4][4];
      zero_acc(acc);
      mainloop(acc, LA + 128, LAW, mbase, (const h16*)(p.ws + WS_WLG) + (size_t)n0 * 192, 192, 192, lds);
      stage16(acc, TG);
    }
    __syncthreads();
    const int ch = n0 + c8;
    const F8 kac = ld32(p.in[I_KA] + ch), rkc = ld32(p.in[I_RK] + ch), lg = ld32(p.in[I_LNG] + ch), lb = ld32(p.in[I_LNB] + ch);
#pragma unroll 1
    for (int i = 0; i < 8; ++i) {
      const int row = r0 + 16 * i, m = mbase + row;
      const F8 y = ld16(yrow(p, m) + ch);
      const h16* pp = PB + (size_t)m * 3072 + ch;
      const F8 r = ld16(pp), k = ld16(pp + 1024), v = ld16(pp + 2048);
      const F8 a = ld16(AZ + (size_t)m * DM + ch), g = ld16(TG + row * 128 + c8);
      F8 kp; kp.a = k.a * (1.f + (a.a - 1.f) * kac.a); kp.b = k.b * (1.f + (a.b - 1.f) * kac.b);
      const f32x4 rk4 = r.a * kp.a * rkc.a + r.b * kp.b * rkc.b;
      const float rk = row8_sum((rk4.x + rk4.y) + (rk4.z + rk4.w));
      const f32x4 ys = y.a + y.b;
      const float mean = row8_sum((ys.x + ys.y) + (ys.z + ys.w)) * (1.f / 64.f);
      F8 d; d.a = y.a - mean; d.b = y.b - mean;
      const f32x4 d2 = d.a * d.a + d.b * d.b;
      const float var = row8_sum((d2.x + d2.y) + (d2.z + d2.w)) * (1.f / 64.f);
      const float rs = rsqrtf(var + 64e-5f);
      F8 z;
      z.a = (d.a * rs * lg.a + lb.a + v.a * rk) * g.a;
      z.b = (d.b * rs * lg.b + lb.b + v.b * rk) * g.b;
      st16(AZ + (size_t)m * DM + ch, z);
    }
    __syncthreads();
  }
}

FI void phase4(const Params& p, char* lds) {
  const int tid = threadIdx.x;
  const h16* XN = (const h16*)(p.ws + WS_A);
  const h16* ZA = (const h16*)(p.ws + WS_D);
  const h16* ZB = (const h16*)(p.ws + WS_C);
  const h16* WinT = (const h16*)(p.ws + WS_WIN);
  const h16* WA = (const h16*)(p.ws + WS_WA);
  const h16* WB = (const h16*)(p.ws + WS_WB);
  h16* MG = (h16*)(p.ws + WS_B);
  h16* G2 = (h16*)(p.ws + WS_B + OUT_Y_BYTES);
  h16* T0 = (h16*)lds; h16* T1 = T0 + 16384;
  const int c8 = (tid & 15) * 8, r0 = tid >> 4;
  for (int it = blockIdx.x; it < 8 * NMT; it += gridDim.x) {
    const int j = it / NMT, mt = it - j * NMT;
    const int mbase = mt * 128, n0 = j * 128, n = n0 + c8;
    {
      f32x4 acc[4][4], acc2[4][4];
      zero_acc(acc); zero_acc(acc2);
      mainloop2(acc, acc2, XN, DM, mbase, WinT + (size_t)(6528 + n0) * DM, WinT + (size_t)(7552 + n0) * DM, DM, DM, lds);
      stage16(acc, T0); stage16(acc2, T1);
    }
    __syncthreads();
    {
      const F8 ba = ld32(p.in[I_BG] + n), bb = ld32(p.in[I_BG] + 1024 + n);
#pragma unroll 1
      for (int i = 0; i < 8; ++i) {
        const int row = r0 + 16 * i; const size_t o = (size_t)(mbase + row) * DM + n;
        const F8 a = ld16(T0 + row * 128 + c8), b = ld16(T1 + row * 128 + c8);
        const f32x4 xa = a.a + ba.a, xb = a.b + ba.b, ya = b.a + bb.a, yb = b.b + bb.b;
        F8 ga, gb;
        ga.a = f32x4{sigm(xa.x), sigm(xa.y), sigm(xa.z), sigm(xa.w)}; ga.b = f32x4{sigm(xb.x), sigm(xb.y), sigm(xb.z), sigm(xb.w)};
        gb.a = f32x4{sigm(ya.x), sigm(ya.y), sigm(ya.z), sigm(ya.w)}; gb.b = f32x4{sigm(yb.x), sigm(yb.y), sigm(yb.z), sigm(yb.w)};
        st16(MG + o, ga); st16(G2 + o, gb);
      }
    }
    __syncthreads();
  }
  for (int it = blockIdx.x; it < 8 * NMT; it += gridDim.x) {
    const int j = it / NMT, mt = it - j * NMT;
    const int mbase = mt * 128, n0 = j * 128, n = n0 + c8;
    {
      uint32_t pk[4][4][2];
#pragma unroll 1
      for (int pass = 0; pass < 2; ++pass) {
        f32x4 acc[4][4];
        zero_acc(acc);
        mainloop(acc, pass == 0 ? ZA : ZB, DM, mbase, (pass == 0 ? WA : WB) + (size_t)n0 * DM, DM, DM, lds);
        if (pass == 0) pack_acc(acc, pk);
        else { stage16_pk(pk, T0); stage16(acc, T1); }
      }
    }
    __syncthreads();
#pragma unroll 1
    for (int i = 0; i < 8; ++i) {
      const int row = r0 + 16 * i; const size_t o = (size_t)(mbase + row) * DM + n;
      const h16x8 oa = *(const h16x8*)(T0 + row * 128 + c8), ob = *(const h16x8*)(T1 + row * 128 + c8);
      const h16x8 ga = *(const h16x8*)(MG + o), gb = *(const h16x8*)(G2 + o);
      *(h16x8*)(MG + o) = ga * oa + gb * ob;
    }
    __syncthreads();
  }
}

FI void phase5(const Params& p, char* lds) {
  const int tid = threadIdx.x, lane = tid & 63, wave = tid >> 6, wr = wave >> 1, wc = wave & 1;
  const h16* MG = (const h16*)(p.ws + WS_B);
  const h16* WO = (const h16*)(p.ws + WS_WO);
  h16* X1 = (h16*)(p.ws + WS_A);
  for (int it = blockIdx.x; it < 8 * NMT; it += gridDim.x) {
    const int j = it / NMT, mt = it - j * NMT;
    const int mbase = mt * 128, n0 = j * 128;
    f32x4 acc[4][4];
    zero_acc(acc);
    mainloop(acc, MG, DM, mbase, WO + (size_t)n0 * DM, DM, DM, lds);
    stage_acc(acc, (float*)lds);
    __syncthreads();
    {
      const float* T = (const float*)lds;
      const int c8 = (tid & 15) * 8, r0 = tid >> 4, n = n0 + c8;
#pragma unroll 1
      for (int i = 0; i < 8; ++i) {
        const int row = r0 + 16 * i, m = mbase + row;
        const F8 a = ld32(T + row * 128 + c8), x = ld32(xrow(p, m) + n);
        F8 o; o.a = x.a + a.a; o.b = x.b + a.b;
        st16(X1 + (size_t)m * DM + n, o);
      }
    }
    __syncthreads();
  }
}

FI void phase7(const Params& p, char* lds) {
  const int tid = threadIdx.x;
  const h16* XN2 = (const h16*)(p.ws + WS_D);
  const h16* WUP = (const h16*)(p.ws + WS_WUP);
  h16* HH = (h16*)(p.ws + WS_B);
  h16* TG = (h16*)lds; h16* TV = TG + 16384;
  const int c8 = (tid & 15) * 8, r0 = tid >> 4;
  for (int it = blockIdx.x; it < 22 * NMT_H; it += gridDim.x) {
    const int j = it / NMT_H, mt = it - j * NMT_H;
    const int mbase = mt * 126 - 2, n0 = j * 128;
    {
      f32x4 acc[4][4], acc2[4][4];
      zero_acc(acc); zero_acc(acc2);
      mainloop2(acc, acc2, XN2, DM, mbase, WUP + (size_t)n0 * DM, WUP + (size_t)(DFF + n0) * DM, DM, DM, lds);
      stage16(acc, TG); stage16(acc2, TV);
    }
    __syncthreads();
    const int cgc = n0 + c8, cvc = DFF + n0 + c8;
    const float* cw = p.in[I_CFFN];
    const h16x8 g0 = cvth(ld32(cw + cgc)), g1 = cvth(ld32(cw + 5632 + cgc)), g2 = cvth(ld32(cw + 11264 + cgc));
    const h16x8 v0 = cvth(ld32(cw + cvc)), v1 = cvth(ld32(cw + 5632 + cvc)), v2 = cvth(ld32(cw + 11264 + cvc));
#pragma unroll 1
    for (int i = 0; i < 8; ++i) {
      const int row = r0 + 16 * i, m = mbase + row;
      if (row < 2 || m >= MTOK) continue;
      const Tok k = tokinfo(m);
      const h16x8 gc = *(const h16x8*)(TG + row * 128 + c8), vc = *(const h16x8*)(TV + row * 128 + c8);
      h16x8 gp1, gp2, vp1, vp2;
      const float* st = p.in[I_SFFN] + (size_t)(k.seq - 8) * 11264;
      conv_prev16(TG, row, c8, k, st + cgc, 5632, gp1, gp2);
      conv_prev16(TV, row, c8, k, st + cvc, 5632, vp1, vp2);
      const h16x8 cgh = g0 * gp2 + g1 * gp1 + g2 * gc;
      const h16x8 cvh = v0 * vp2 + v1 * vp1 + v2 * vc;
      const F8 cg_ = cvtf(cgh);
      F8 sl;
      sl.a = f32x4{cg_.a.x * sigm(cg_.a.x), cg_.a.y * sigm(cg_.a.y), cg_.a.z * sigm(cg_.a.z), cg_.a.w * sigm(cg_.a.w)};
      sl.b = f32x4{cg_.b.x * sigm(cg_.b.x), cg_.b.y * sigm(cg_.b.y), cg_.b.z * sigm(cg_.b.z), cg_.b.w * sigm(cg_.b.w)};
      *(h16x8*)(HH + (size_t)m * DFF + n0 + c8) = cvth(sl) * cvh;
      if (k.t >= k.T - 2) {
        float* fo = p.out + O_FFN + (size_t)k.seq * 11264 + (k.t - (k.T - 2)) * 5632;
        st32(fo + cgc, cvtf(gc)); st32(fo + cvc, cvtf(vc));
      }
    }
    __syncthreads();
  }
}

FI void phase8(const Params& p, char* lds) {
  const int tid = threadIdx.x, lane = tid & 63, wave = tid >> 6, wr = wave >> 1, wc = wave & 1;
  const h16* HH = (const h16*)(p.ws + WS_B);
  const h16* WDN = (const h16*)(p.ws + WS_WDN);
  h16* X1 = (h16*)(p.ws + WS_A);
  for (int it = blockIdx.x; it < 8 * NMT; it += gridDim.x) {
    const int j = it / NMT, mt = it - j * NMT;
    const int mbase = mt * 128, n0 = j * 128;
    f32x4 acc[4][4];
    zero_acc(acc);
    mainloop(acc, HH, DFF, mbase, WDN + (size_t)n0 * DFF, DFF, DFF, lds);
    stage_acc(acc, (float*)lds);
    __syncthreads();
    {
      const float* T = (const float*)lds;
      const int c8 = (tid & 15) * 8, r0 = tid >> 4, n = n0 + c8;
#pragma unroll 1
      for (int i = 0; i < 8; ++i) {
        const int row = r0 + 16 * i, m = mbase + row;
        h16* q = X1 + (size_t)m * DM + n;
        const F8 a = ld32(T + row * 128 + c8), x = ld16(q);
        F8 o; o.a = x.a + a.a; o.b = x.b + a.b;
        st16(q, o);
      }
    }
    __syncthreads();
  }
}

constexpr int NPHASE = 11;

#define XB_TMO      128
#define XB_XCNT(j)  (256  + 64 * (j))
#define XB_XSUB(j)  (1280 + 64 * (j))
#define XB_XGEN(j)  (2304 + 64 * (j))
#define XB_TOP      3328
#define XB_TOPGEN   3392
#define XCD_BAR_WORDS 3456
#define XB_SPIN_CAP (1u << 18)
FI unsigned xb_ld(unsigned* p)              { return __hip_atomic_load(p, __ATOMIC_RELAXED, __HIP_MEMORY_SCOPE_AGENT); }
FI unsigned xb_add(unsigned* p, unsigned v) { return __hip_atomic_fetch_add(p, v, __ATOMIC_RELAXED, __HIP_MEMORY_SCOPE_AGENT); }
FI unsigned xb_xcc_id() { return (unsigned)__builtin_amdgcn_s_getreg((3 << 11) | 20) & 0xFu; }
#define XB_SPIN(cond, bar) do { unsigned _sp = 0; while (cond) { __builtin_amdgcn_s_sleep(1); \
    if ((++_sp & 255u) == 0u) { if (xb_ld(&(bar)[XB_TMO])) break; if (_sp > XB_SPIN_CAP) { atomicAdd(&(bar)[XB_TMO], 1u); break; } } } } while (0)
struct XcdBarrier { unsigned* bar; unsigned x; volatile unsigned* st; };
FI XcdBarrier xcd_barrier_post(unsigned* bar, volatile unsigned* st) {
  XcdBarrier b; b.bar = bar; b.x = xb_xcc_id(); b.st = st;
  if (threadIdx.x == 0) (void)xb_add(&bar[XB_XCNT(b.x)], 1u);
  return b;
}
FI void xcd_barrier_complete(unsigned* bar, unsigned x, unsigned& nloc, unsigned& nx) {
  const unsigned G = gridDim.x * gridDim.y * gridDim.z;
  unsigned sum, cnt, mine, sp = 0u;
  for (;;) {
    sum = 0u; cnt = 0u; mine = 0u;
#pragma unroll
    for (unsigned j = 0; j < 16; ++j) { const unsigned c = xb_ld(&bar[XB_XCNT(j)]); sum += c; cnt += (c > 0u) ? 1u : 0u; mine = (j == x) ? c : mine; }
    if (sum == G) break;
    __builtin_amdgcn_s_sleep(1);
    if ((++sp & 255u) == 0u) { if (xb_ld(&bar[XB_TMO])) break; if (sp > XB_SPIN_CAP) { atomicAdd(&bar[XB_TMO], 1u); break; } }
  }
  nloc = mine > 0u ? mine : 1u; nx = cnt > 0u ? cnt : 1u;
}
FI void xcd_barrier(const XcdBarrier& b) {
  asm volatile("s_waitcnt vmcnt(0)" ::: "memory");
  __syncthreads();
  if (threadIdx.x == 0) {
    unsigned* bar = b.bar;
    __builtin_amdgcn_s_waitcnt(0);
    unsigned nloc = b.st[0], nx = b.st[1];
    if (nloc == 0u) { xcd_barrier_complete(bar, b.x, nloc, nx); b.st[0] = nloc; b.st[1] = nx; }
    const unsigned old = xb_add(&bar[XB_XSUB(b.x)], 1u);
    const unsigned gen = old / nloc;
    if (old + 1u == (gen + 1u) * nloc) {
      __builtin_amdgcn_fence(__ATOMIC_RELEASE, "agent");
      asm volatile("s_waitcnt vmcnt(0)" ::: "memory");
      const unsigned og = xb_add(&bar[XB_TOP], 1u);
      const unsigned tg = og / nx;
      if (og + 1u == (tg + 1u) * nx) xb_add(&bar[XB_TOPGEN], 1u);
      else XB_SPIN(xb_ld(&bar[XB_TOPGEN]) == tg, bar);
      __builtin_amdgcn_fence(__ATOMIC_ACQUIRE, "agent");
      xb_add(&bar[XB_XGEN(b.x)], 1u);
      asm volatile("s_waitcnt vmcnt(0)" ::: "memory");
    } else {
      XB_SPIN(xb_ld(&bar[XB_XGEN(b.x)]) == gen, bar);
      __builtin_amdgcn_fence(__ATOMIC_ACQUIRE, "agent");
      asm volatile("s_waitcnt vmcnt(0)" ::: "memory");
    }
  }
  __syncthreads();
}

template <int PH> FI void run_phase(const Params& p, char* lds) {
  if (PH == 0) phase0(p, lds);
  if (PH == 1) phase1(p, lds);
  if (PH == 2) phaseA(p, lds);
  if (PH == 3) phase3(p, lds);
  if (PH == 4) phase3b(p, lds);
  if (PH == 5) phase4(p, lds);
  if (PH == 6) phase5(p, lds);
  if (PH == 7) rms_rows(p, 1, (const float*)(p.ws + WS_A), p.in[I_N2G], (h16*)(p.ws + WS_D), blockIdx.x * 4 + (threadIdx.x >> 6), gridDim.x * 4);
  if (PH == 8) phase7(p, lds);
  if (PH == 9) phase8(p, lds);
  if (PH == 10) rms_rows(p, 2, (const float*)(p.ws + WS_A), p.in[I_FNG], nullptr, blockIdx.x * 4 + (threadIdx.x >> 6), gridDim.x * 4);
}

template <int PH> __global__ void __launch_bounds__(256, 1) mega_one(Params p) {
  __shared__ __attribute__((aligned(16))) char lds[65536];
  run_phase<PH>(p, lds);
}

#if N_LAUNCH_MODE == 1
__global__ void __launch_bounds__(256, 2) mega(Params p) {
  __shared__ __attribute__((aligned(16))) char lds[65536 + 16];
  volatile unsigned* st = (volatile unsigned*)(lds + 65536);
  if (threadIdx.x < 4) st[threadIdx.x] = 0u;
  __syncthreads();
  if (p.ph_lo < 0) cg::this_grid().sync();
  XcdBarrier xb = xcd_barrier_post((unsigned*)(p.ws + WS_END), st);
  run_phase<0>(p, lds); xcd_barrier(xb);
  run_phase<1>(p, lds); xcd_barrier(xb);
  run_phase<2>(p, lds); xcd_barrier(xb);
  run_phase<3>(p, lds); xcd_barrier(xb);
  run_phase<4>(p, lds); xcd_barrier(xb);
  run_phase<5>(p, lds); xcd_barrier(xb);
  run_phase<6>(p, lds); xcd_barrier(xb);
  run_phase<7>(p, lds); xcd_barrier(xb);
  run_phase<8>(p, lds); xcd_barrier(xb);
  run_phase<9>(p, lds); xcd_barrier(xb);
  run_phase<10>(p, lds);
}
#endif

extern "C" void kernel_launch(void* const* d_in, const int* in_sizes, int n_in, void* d_out, int out_size,
                              void* d_ws, size_t ws_size, hipStream_t stream) {
  static int grid = 0;
  if (!grid) {
    int dev = 0, cus = 0, per_cu = 0;
    (void)hipGetDevice(&dev);
    (void)hipDeviceGetAttribute(&cus, hipDeviceAttributeMultiprocessorCount, dev);
#if N_LAUNCH_MODE == 1
    (void)hipOccupancyMaxActiveBlocksPerMultiprocessor(&per_cu, mega, 256, 0);
#else
    per_cu = 2;
#endif
    if (per_cu < 1) per_cu = 1;
    if (per_cu > 2) per_cu = 2;
    grid = cus * per_cu;
    if (ws_size < WS_YS + 1048576) fprintf(stderr, "workspace too small: %zu < %zu\n", ws_size, (size_t)WS_END);
  }
  Params p{};
  for (int i = 0; i < 30; ++i) p.in[i] = (const float*)d_in[i];
  p.out = (float*)d_out;
  p.ws = (char*)d_ws;
#if N_LAUNCH_MODE == 1
  p.ph_lo = 0; p.ph_hi = NPHASE;
  (void)hipMemsetAsync((char*)d_ws + WS_END, 0, XCD_BAR_WORDS * 4, stream);
  void* args[] = {&p};
  hipError_t e = hipLaunchCooperativeKernel((void*)mega, dim3(grid), dim3(256), args, 0, stream);
  if (e != hipSuccess) fprintf(stderr, "cooperative launch failed: %s (grid %d)\n", hipGetErrorString(e), grid);
#else
  p.ph_lo = 0; p.ph_hi = NPHASE;
  hipLaunchKernelGGL(mega_one<0>, dim3(grid), dim3(256), 0, stream, p);
  hipLaunchKernelGGL(mega_one<1>, dim3(grid), dim3(256), 0, stream, p);
  hipLaunchKernelGGL(mega_one<2>, dim3(grid), dim3(256), 0, stream, p);
  hipLaunchKernelGGL(mega_one<3>, dim3(grid), dim3(256), 0, stream, p);
  hipLaunchKernelGGL(mega_one<4>, dim3(grid), dim3(256), 0, stream, p);
  hipLaunchKernelGGL(mega_one<5>, dim3(grid), dim3(256), 0, stream, p);
  hipLaunchKernelGGL(mega_one<6>, dim3(grid), dim3(256), 0, stream, p);
  hipLaunchKernelGGL(mega_one<7>, dim3(grid), dim3(256), 0, stream, p);
  hipLaunchKernelGGL(mega_one<8>, dim3(grid), dim3(256), 0, stream, p);
  hipLaunchKernelGGL(mega_one<9>, dim3(grid), dim3(256), 0, stream, p);
  hipLaunchKernelGGL(mega_one<10>, dim3(grid), dim3(256), 0, stream, p);
#endif
}
```

```cpp
#include <hip/hip_runtime.h>
#include <hip/hip_cooperative_groups.h>
#include <stdint.h>
#include <stdio.h>
namespace cg = cooperative_groups;

#ifndef N_LAUNCH_MODE
#define N_LAUNCH_MODE 1
#endif

typedef _Float16 h16;
typedef _Float16 h16x8 __attribute__((ext_vector_type(8)));
typedef _Float16 h16x4 __attribute__((ext_vector_type(4)));
typedef float f32x16 __attribute__((ext_vector_type(16)));
typedef float f32x4 __attribute__((ext_vector_type(4)));
typedef float f32x2 __attribute__((ext_vector_type(2)));

#define FI __device__ __forceinline__

constexpr int DM = 1024;
constexpr int MTOK = 17024;
constexpr int TPR = 2064;
constexpr int NPTOK = 16512;
constexpr int RWP = 3360;
constexpr int PTOT = 8480;
constexpr int DFF = 2816;
constexpr int LAW = 320;
constexpr int NMT_H = 136;
constexpr int NMT = 133;

constexpr size_t O_YP = 0, O_YS = 16777216, O_WKV = 17301504, O_SH = 26214400, O_SC = 26671360, O_FFN = 26949888;

constexpr size_t WS_WIN = 0;
constexpr size_t WS_WA = 17563648, WS_WB = 19660800, WS_WO = 21757952;
constexpr size_t WS_WUP = 23855104, WS_WDN = 35389440;
constexpr size_t WS_WLD = 41156608, WS_WLA = 41287680, WS_WLG = 41418752;
constexpr size_t WS_B = 41811968;
constexpr size_t WS_A = 146407424;
constexpr size_t WS_C = 181272576;
constexpr size_t WS_D = 216137728;
constexpr size_t WS_E = 251002880;
constexpr size_t WS_END = 261898240;

struct Params {
  const float* in[30];
  float* out;
  char* ws;
  int ph_lo, ph_hi;
};

enum { I_XP = 0, I_XS, I_SWKV, I_SSH, I_SSC, I_SFFN, I_META, I_N1G, I_WIN, I_BG, I_MU, I_W0, I_WDEC, I_A0, I_WAAA,
       I_WGATE, I_KK, I_KA, I_RK, I_LNG, I_LNB, I_WBR, I_WBS, I_CSC, I_WOUT, I_N2G, I_WUP, I_CFFN, I_WDN, I_FNG };

FI float sigm(float x) { return __builtin_amdgcn_rcpf(1.f + __expf(-x)); }
FI float tanh_(float x) { return 1.f - 2.f * __builtin_amdgcn_rcpf(1.f + __expf(2.f * x)); }
FI float wave_sum(float v) {
#pragma unroll
  for (int o = 32; o; o >>= 1) v += __shfl_xor(v, o);
  return v;
}
FI float sum16(float v) {
#pragma unroll
  for (int o = 8; o; o >>= 1) v += __shfl_xor(v, o);
  return v;
}
FI float quad_sum(float v) {
  float t = __builtin_bit_cast(float, __builtin_amdgcn_update_dpp(0, __builtin_bit_cast(int, v), 0xB1, 0xF, 0xF, true));
  v += t;
  t = __builtin_bit_cast(float, __builtin_amdgcn_update_dpp(0, __builtin_bit_cast(int, v), 0x4E, 0xF, 0xF, true));
  return v + t;
}
struct Tok { int seq, t, T; };
FI Tok tokinfo(int m) {
  Tok k;
  if (m < NPTOK) { k.seq = m / TPR; k.t = m - k.seq * TPR; k.T = TPR; }
  else { int mm = m - NPTOK; k.seq = 8 + (mm >> 2); k.t = mm & 3; k.T = 4; }
  return k;
}
FI const float* xrow(const Params& p, int m) {
  if (m < NPTOK) {
    int s = m / TPR, t = m - s * TPR;
    return t < 16 ? p.in[I_META] + t * DM : p.in[I_XP] + ((size_t)s * 2048 + (t - 16)) * DM;
  }
  return p.in[I_XS] + (size_t)(m - NPTOK) * DM;
}

FI int swz(int row, int chunk) { return row * 128 + ((chunk ^ ((row >> 1) & 7)) << 4); }

FI void zero_acc(f32x4 (&acc)[4][4]) {
#pragma unroll
  for (int a = 0; a < 4; ++a)
#pragma unroll
    for (int b = 0; b < 4; ++b) acc[a][b] = f32x4{0.f, 0.f, 0.f, 0.f};
}

FI void mainloop(f32x4 (&acc)[4][4], const h16* __restrict__ A, int lda, int mbase,
                 const h16* __restrict__ BT, int ldb, int K, char* lds) {
  const int tid = threadIdx.x, lane = tid & 63, wave = tid >> 6, wr = wave >> 1, wc = wave & 1;
  uint32_t aoff[4], boff[4];
#pragma unroll
  for (int i = 0; i < 4; ++i) {
    const int row = wave * 32 + i * 8 + (lane >> 3);
    const int chunk = (lane & 7) ^ ((row >> 1) & 7);
    int m = mbase + row; m = m < 0 ? 0 : (m > MTOK - 1 ? MTOK - 1 : m);
    aoff[i] = (uint32_t)m * lda + chunk * 8;
    boff[i] = (uint32_t)row * ldb + chunk * 8;
  }
  const int ldsw = wave * 4096 + lane * 16;
#define ML_ISSUE(KT, BUF) do { _Pragma("unroll") for (int i = 0; i < 4; ++i) { \
    __builtin_amdgcn_global_load_lds((const unsigned*)(A + aoff[i] + (KT) * 64), (unsigned*)(lds + (BUF) * 32768 + ldsw + i * 1024), 16, 0, 0); \
    __builtin_amdgcn_global_load_lds((const unsigned*)(BT + boff[i] + (KT) * 64), (unsigned*)(lds + (BUF) * 32768 + 16384 + ldsw + i * 1024), 16, 0, 0); } } while (0)
  const int nk = K >> 6;
  const int rA0 = wr * 64 + (lane & 15), rB0 = wc * 64 + (lane & 15), hh = lane >> 4;
  ML_ISSUE(0, 0);
  for (int kt = 0; kt < nk; ++kt) {
    const int buf = kt & 1;
    asm volatile("s_waitcnt vmcnt(0)" ::: "memory");
    __syncthreads();
    if (kt + 1 < nk) ML_ISSUE(kt + 1, buf ^ 1);
    const char* la = lds + buf * 32768;
    const char* lb = la + 16384;
#pragma unroll
    for (int ks = 0; ks < 2; ++ks) {
      h16x8 a[4], b[4];
#pragma unroll
      for (int t = 0; t < 4; ++t) {
        a[t] = *(const h16x8*)(la + swz(rA0 + t * 16, ks * 4 + hh));
        b[t] = *(const h16x8*)(lb + swz(rB0 + t * 16, ks * 4 + hh));
      }
#pragma unroll
      for (int ti = 0; ti < 4; ++ti)
#pragma unroll
        for (int tj = 0; tj < 4; ++tj) acc[ti][tj] = __builtin_amdgcn_mfma_f32_16x16x32_f16(a[ti], b[tj], acc[ti][tj], 0, 0, 0);
    }
  }
  __syncthreads();
#undef ML_ISSUE
}

FI int swz32(int row, int chunk) { return row * 64 + ((chunk ^ ((0 - (row >> 2)) & 3)) << 4); }
FI void mainloop2(f32x4 (&acc)[4][4], f32x4 (&acc2)[4][4], const h16* __restrict__ A, int lda, int mbase,
                  const h16* __restrict__ BT1, const h16* __restrict__ BT2, int ldb, int K, char* lds) {
  const int tid = threadIdx.x, lane = tid & 63, wave = tid >> 6, wr = wave >> 1, wc = wave & 1;
  uint32_t aoff[2], boff[2];
#pragma unroll
  for (int i = 0; i < 2; ++i) {
    const int row = wave * 32 + i * 16 + (lane >> 2);
    const int chunk = (lane & 3) ^ ((0 - (row >> 2)) & 3);
    int m = mbase + row; m = m < 0 ? 0 : (m > MTOK - 1 ? MTOK - 1 : m);
    aoff[i] = (uint32_t)m * lda + chunk * 8;
    boff[i] = (uint32_t)row * ldb + chunk * 8;
  }
  const int ldsw = wave * 2048 + lane * 16;
#define ML2_ISSUE(KT, BUF) do { _Pragma("unroll") for (int i = 0; i < 2; ++i) { \
    __builtin_amdgcn_global_load_lds((const unsigned*)(A + aoff[i] + (KT) * 32), (unsigned*)(lds + (BUF) * 24576 + ldsw + i * 1024), 16, 0, 0); \
    __builtin_amdgcn_global_load_lds((const unsigned*)(BT1 + boff[i] + (KT) * 32), (unsigned*)(lds + (BUF) * 24576 + 8192 + ldsw + i * 1024), 16, 0, 0); \
    __builtin_amdgcn_global_load_lds((const unsigned*)(BT2 + boff[i] + (KT) * 32), (unsigned*)(lds + (BUF) * 24576 + 16384 + ldsw + i * 1024), 16, 0, 0); } } while (0)
  const int nk = K >> 5;
  const int rA0 = wr * 64 + (lane & 15), rB0 = wc * 64 + (lane & 15), hh = lane >> 4;
  ML2_ISSUE(0, 0);
  for (int kt = 0; kt < nk; ++kt) {
    const int buf = kt & 1;
    asm volatile("s_waitcnt vmcnt(0)" ::: "memory");
    __syncthreads();
    if (kt + 1 < nk) ML2_ISSUE(kt + 1, buf ^ 1);
    const char* la = lds + buf * 24576;
    const char* lb = la + 8192;
    const char* lc = la + 16384;
    {
      h16x8 a[4], b[4], c[4];
#pragma unroll
      for (int t = 0; t < 4; ++t) {
        a[t] = *(const h16x8*)(la + swz32(rA0 + t * 16, hh));
        b[t] = *(const h16x8*)(lb + swz32(rB0 + t * 16, hh));
        c[t] = *(const h16x8*)(lc + swz32(rB0 + t * 16, hh));
      }
#pragma unroll
      for (int ti = 0; ti < 4; ++ti)
#pragma unroll
        for (int tj = 0; tj < 4; ++tj) {
          acc[ti][tj] = __builtin_amdgcn_mfma_f32_16x16x32_f16(a[ti], b[tj], acc[ti][tj], 0, 0, 0);
          acc2[ti][tj] = __builtin_amdgcn_mfma_f32_16x16x32_f16(a[ti], c[tj], acc2[ti][tj], 0, 0, 0);
        }
    }
  }
  __syncthreads();
#undef ML2_ISSUE
}

#define CROW(ti, reg) (wr * 64 + (ti) * 16 + 4 * (lane >> 4) + (reg))
#define CCOL(tj) (wc * 64 + (tj) * 16 + (lane & 15))

FI void stage_acc(const f32x4 (&acc)[4][4], float* T) {
  const int tid = threadIdx.x, lane = tid & 63, wave = tid >> 6, wr = wave >> 1, wc = wave & 1;
#pragma unroll
  for (int ti = 0; ti < 4; ++ti)
#pragma unroll
    for (int tj = 0; tj < 4; ++tj)
#pragma unroll
      for (int r = 0; r < 4; ++r) T[CROW(ti, r) * 128 + CCOL(tj)] = acc[ti][tj][r];
}

FI int win_map(int dr) {
  if (dr < 3360) return dr;
  if (dr < 3456) return -1;
  if (dr < 4480) return 3360 + (dr - 3456);
  if (dr < 5504) return 5408 + (dr - 4480);
  if (dr < 6528) return 4384 + (dr - 5504);
  return 6432 + (dr - 6528);
}
FI void transpose_tile(const float* __restrict__ src, int ldsrc, int Ksrc, int Nsrc, int mode, int rt, int ktile,
                       h16* __restrict__ dst, int lddst, float* sm) {
  const int tid = threadIdx.x;
  {
    const int rr = tid & 63, kq = tid >> 6;
    const int dr = rt * 64 + rr;
    int col = mode ? win_map(dr) : (dr < Nsrc ? dr : -1);
#pragma unroll
    for (int i = 0; i < 16; ++i) {
      int kk = kq + 4 * i, k = ktile * 64 + kk;
      float v = (col >= 0 && k < Ksrc) ? src[(size_t)k * ldsrc + col] : 0.f;
      sm[kk * 65 + rr] = v;
    }
  }
  __syncthreads();
  {
    const int dr = tid >> 2, seg = tid & 3;
    h16x8 o0, o1;
#pragma unroll
    for (int j = 0; j < 8; ++j) { o0[j] = (h16)sm[(seg * 16 + j) * 65 + dr]; o1[j] = (h16)sm[(seg * 16 + 8 + j) * 65 + dr]; }
    h16* d = dst + (size_t)(rt * 64 + dr) * lddst + ktile * 64 + seg * 16;
    *(h16x8*)d = o0; *(h16x8*)(d + 8) = o1;
  }
  __syncthreads();
}

FI void rms_rows(const Params& p, int mode, const float* __restrict__ src, const float* __restrict__ g, h16* dsth, int gw, int nw) {
  const int lane = threadIdx.x & 63;
  for (int m = gw; m < MTOK; m += nw) {
    f32x4 v[4]; float ss = 0.f;
    if (mode == 0) {
      const float* row = xrow(p, m);
#pragma unroll
      for (int i = 0; i < 4; ++i) v[i] = *(const f32x4*)(row + lane * 4 + 256 * i);
    } else {
      const h16* row = (const h16*)src + (size_t)m * DM;
#pragma unroll
      for (int i = 0; i < 4; ++i) { const h16x4 h = *(const h16x4*)(row + lane * 4 + 256 * i); v[i] = f32x4{(float)h[0], (float)h[1], (float)h[2], (float)h[3]}; }
    }
#pragma unroll
    for (int i = 0; i < 4; ++i) ss += v[i].x * v[i].x + v[i].y * v[i].y + v[i].z * v[i].z + v[i].w * v[i].w;
    ss = wave_sum(ss);
    const float rs = rsqrtf(ss * (1.f / DM) + 1e-6f);
    if (mode == 2) {
      float* o;
      if (m < NPTOK) { int s = m / TPR, t = m - s * TPR; if (t < 16) continue; o = p.out + O_YP + ((size_t)s * 2048 + (t - 16)) * DM; }
      else o = p.out + O_YS + (size_t)(m - NPTOK) * DM;
#pragma unroll
      for (int i = 0; i < 4; ++i) { f32x4 gg = *(const f32x4*)(g + lane * 4 + 256 * i); f32x4 r = v[i] * rs * gg; *(f32x4*)(o + lane * 4 + 256 * i) = r; }
    } else {
#pragma unroll
      for (int i = 0; i < 4; ++i) {
        f32x4 gg = *(const f32x4*)(g + lane * 4 + 256 * i); f32x4 r = v[i] * rs * gg;
        h16x4 h; h[0] = (h16)r.x; h[1] = (h16)r.y; h[2] = (h16)r.z; h[3] = (h16)r.w;
        *(h16x4*)(dsth + (size_t)m * DM + lane * 4 + 256 * i) = h;
      }
    }
  }
}

FI void transpose_item(const Params& p, float* sm, int it) {
  {
    int i = it;
    if (i < 2144) { transpose_tile(p.in[I_WIN], PTOT, 1024, PTOT, 1, i >> 4, i & 15, (h16*)(p.ws + WS_WIN), 1024, sm); return; }
    i -= 2144;
    if (i < 256) { transpose_tile(p.in[I_WBR], 1024, 1024, 1024, 0, i >> 4, i & 15, (h16*)(p.ws + WS_WA), 1024, sm); return; }
    i -= 256;
    if (i < 256) { transpose_tile(p.in[I_WBS], 1024, 1024, 1024, 0, i >> 4, i & 15, (h16*)(p.ws + WS_WB), 1024, sm); return; }
    i -= 256;
    if (i < 256) { transpose_tile(p.in[I_WOUT], 1024, 1024, 1024, 0, i >> 4, i & 15, (h16*)(p.ws + WS_WO), 1024, sm); return; }
    i -= 256;
    if (i < 1408) { transpose_tile(p.in[I_WUP], 5632, 1024, 5632, 0, i >> 4, i & 15, (h16*)(p.ws + WS_WUP), 1024, sm); return; }
    i -= 1408;
    if (i < 704) { transpose_tile(p.in[I_WDN], 1024, 2816, 1024, 0, i / 44, i % 44, (h16*)(p.ws + WS_WDN), 2816, sm); return; }
    i -= 704;
    if (i < 16) { transpose_tile(p.in[I_WDEC], 1024, 64, 1024, 0, i, 0, (h16*)(p.ws + WS_WLD), 64, sm); return; }
    i -= 16;
    if (i < 16) { transpose_tile(p.in[I_WAAA], 1024, 64, 1024, 0, i, 0, (h16*)(p.ws + WS_WLA), 64, sm); return; }
    i -= 16;
    transpose_tile(p.in[I_WGATE], 1024, 160, 1024, 0, i / 3, i % 3, (h16*)(p.ws + WS_WLG), 192, sm);
  }
}

FI void phase0(const Params& p, char* lds) {
  float* sm = (float*)lds;
  h16* ws = (h16*)p.ws;
  for (int it = blockIdx.x; it < 2144 + 80; it += gridDim.x) transpose_item(p, sm, it < 2144 ? it : it + 2880);
  (void)ws;
  rms_rows(p, 0, nullptr, p.in[I_N1G], (h16*)(p.ws + WS_A), blockIdx.x * 4 + (threadIdx.x >> 6), gridDim.x * 4);
}

struct F8 { f32x4 a, b; };
FI F8 ld16(const h16* q) { h16x8 v = *(const h16x8*)q; F8 r; r.a = f32x4{(float)v[0], (float)v[1], (float)v[2], (float)v[3]}; r.b = f32x4{(float)v[4], (float)v[5], (float)v[6], (float)v[7]}; return r; }
FI F8 ld32(const float* q) { F8 r; r.a = *(const f32x4*)q; r.b = *(const f32x4*)(q + 4); return r; }
FI F8 zero8() { F8 r; r.a = f32x4{0.f, 0.f, 0.f, 0.f}; r.b = r.a; return r; }
FI void st16(h16* q, const F8& v) { h16x8 h; h[0] = (h16)v.a.x; h[1] = (h16)v.a.y; h[2] = (h16)v.a.z; h[3] = (h16)v.a.w; h[4] = (h16)v.b.x; h[5] = (h16)v.b.y; h[6] = (h16)v.b.z; h[7] = (h16)v.b.w; *(h16x8*)q = h; }
FI void st32(float* q, const F8& v) { *(f32x4*)q = v.a; *(f32x4*)(q + 4) = v.b; }
FI void stage16(const f32x4 (&acc)[4][4], h16* T) {
  const int tid = threadIdx.x, lane = tid & 63, wave = tid >> 6, wr = wave >> 1, wc = wave & 1;
#pragma unroll
  for (int ti = 0; ti < 4; ++ti)
#pragma unroll
    for (int tj = 0; tj < 4; ++tj)
#pragma unroll
      for (int r = 0; r < 4; ++r) T[CROW(ti, r) * 128 + CCOL(tj)] = (h16)acc[ti][tj][r];
}
typedef _Float16 h16x2 __attribute__((ext_vector_type(2)));
FI void pack_acc(const f32x4 (&acc)[4][4], uint32_t (&pk)[4][4][2]) {
#pragma unroll
  for (int ti = 0; ti < 4; ++ti)
#pragma unroll
    for (int tj = 0; tj < 4; ++tj)
#pragma unroll
      for (int r = 0; r < 4; r += 2) {
        h16x2 h2; h2[0] = (h16)acc[ti][tj][r]; h2[1] = (h16)acc[ti][tj][r + 1];
        pk[ti][tj][r >> 1] = __builtin_bit_cast(uint32_t, h2);
      }
}
FI void stage16_pk(const uint32_t (&pk)[4][4][2], h16* T) {
  const int tid = threadIdx.x, lane = tid & 63, wave = tid >> 6, wr = wave >> 1, wc = wave & 1;
#pragma unroll
  for (int ti = 0; ti < 4; ++ti)
#pragma unroll
    for (int tj = 0; tj < 4; ++tj)
#pragma unroll
      for (int r = 0; r < 4; r += 2) {
        h16x2 h2 = __builtin_bit_cast(h16x2, pk[ti][tj][r >> 1]);
        T[CROW(ti, r) * 128 + CCOL(tj)] = h2[0];
        T[CROW(ti, r + 1) * 128 + CCOL(tj)] = h2[1];
      }
}
FI void conv_prev(const h16* T, int row, int c8, const Tok& k, const float* st  , int ld, F8& p1, F8& p2) {
  if (k.t >= 2) { p1 = ld16(T + (row - 1) * 128 + c8); p2 = ld16(T + (row - 2) * 128 + c8); }
  else if (k.t == 1) { p1 = ld16(T + (row - 1) * 128 + c8); p2 = k.seq >= 8 ? ld32(st + ld) : zero8(); }
  else { if (k.seq >= 8) { p1 = ld32(st + ld); p2 = ld32(st); } else { p1 = zero8(); p2 = zero8(); } }
}

FI h16x8 cvth(const F8& v) { h16x8 h; h[0] = (h16)v.a.x; h[1] = (h16)v.a.y; h[2] = (h16)v.a.z; h[3] = (h16)v.a.w; h[4] = (h16)v.b.x; h[5] = (h16)v.b.y; h[6] = (h16)v.b.z; h[7] = (h16)v.b.w; return h; }
FI F8 cvtf(const h16x8& v) { F8 r; r.a = f32x4{(float)v[0], (float)v[1], (float)v[2], (float)v[3]}; r.b = f32x4{(float)v[4], (float)v[5], (float)v[6], (float)v[7]}; return r; }
FI h16x8 zeroh() { h16x8 h; for (int i = 0; i < 8; ++i) h[i] = (h16)0.f; return h; }
FI void conv_prev16(const h16* T, int row, int c8, const Tok& k, const float* st  , int ld, h16x8& p1, h16x8& p2) {
  if (k.t >= 2) { p1 = *(const h16x8*)(T + (row - 1) * 128 + c8); p2 = *(const h16x8*)(T + (row - 2) * 128 + c8); }
  else if (k.t == 1) { p1 = *(const h16x8*)(T + (row - 1) * 128 + c8); p2 = k.seq >= 8 ? cvth(ld32(st + ld)) : zeroh(); }
  else { if (k.seq >= 8) { p1 = cvth(ld32(st + ld)); p2 = cvth(ld32(st)); } else { p1 = zeroh(); p2 = zeroh(); } }
}

FI void phase1(const Params& p, char* lds) {
  const int tid = threadIdx.x;
  const h16* XN = (const h16*)(p.ws + WS_A);
  const h16* WinT = (const h16*)(p.ws + WS_WIN);
  h16* PB = (h16*)(p.ws + WS_B);
  h16* ZB = (h16*)(p.ws + WS_C);
  h16* LA = (h16*)(p.ws + WS_E);
  const int c8 = (tid & 15) * 8, r0 = tid >> 4;
  for (int it = blockIdx.x; it < 35 * NMT_H; it += gridDim.x) {
    const int j = it / NMT_H, mt = it - j * NMT_H;
    const int mbase = mt * 126 - 2;
    {
      const int npass = j < 8 ? 3 : 1;
      uint32_t pk[4][4][2];
#pragma unroll 1
      for (int pass = 0; pass < npass; ++pass) {
        int brow;
        if (j < 8) brow = (pass == 0 ? 3456 : (pass == 1 ? 4480 : 5504)) + j * 128;
        else brow = (j - 8) * 128;
        f32x4 acc[4][4];
        zero_acc(acc);
        mainloop(acc, XN, DM, mbase, WinT + (size_t)brow * DM, DM, DM, lds);
        if (j < 8) {
          if (pass == 0) pack_acc(acc, pk);
          else if (pass == 1) {
#pragma unroll
            for (int ti = 0; ti < 4; ++ti)
#pragma unroll
              for (int tj = 0; tj < 4; ++tj)
#pragma unroll
                for (int r = 0; r < 4; r += 2) {
                  h16x2 h2 = __builtin_bit_cast(h16x2, pk[ti][tj][r >> 1]);
                  h2[0] = (h16)((float)h2[0] * acc[ti][tj][r]); h2[1] = (h16)((float)h2[1] * acc[ti][tj][r + 1]);
                  pk[ti][tj][r >> 1] = __builtin_bit_cast(uint32_t, h2);
                }
          } else { stage16_pk(pk, (h16*)lds); stage16(acc, (h16*)lds + 16384); }
        } else stage_acc(acc, (float*)lds);
      }
    }
    if (j < 8) {
      const int n0 = j * 128;
      h16* TU = (h16*)lds; h16* TB = TU + 16384;
      __syncthreads();
      const int ch = n0 + c8;
      const float* cw = p.in[I_CSC];
      const h16x8 w0 = cvth(ld32(cw + ch)), w1 = cvth(ld32(cw + 1024 + ch)), w2 = cvth(ld32(cw + 2048 + ch));
#pragma unroll 1
      for (int i = 0; i < 8; ++i) {
        const int row = r0 + 16 * i, m = mbase + row;
        if (row < 2 || m >= MTOK) continue;
        const Tok k = tokinfo(m);
        const h16x8 cur = *(const h16x8*)(TU + row * 128 + c8), bg = *(const h16x8*)(TB + row * 128 + c8);
        h16x8 p1, p2;
        conv_prev16(TU, row, c8, k, p.in[I_SSC] + (size_t)(k.seq - 8) * 2048 + ch, 1024, p1, p2);
        *(h16x8*)(ZB + (size_t)m * DM + ch) = bg * (w0 * p2 + w1 * p1 + w2 * cur);
        if (k.t >= k.T - 2) st32(p.out + O_SC + (size_t)k.seq * 2048 + (k.t - (k.T - 2)) * 1024 + ch, cvtf(cur));
      }
      __syncthreads();
    } else {
      const int n0 = (j - 8) * 128;
      float* T = (float*)lds;
      __syncthreads();
      const int n = n0 + c8;
      const F8 muv = n < RWP ? ld32(p.in[I_MU] + n) : zero8();
#pragma unroll 1
      for (int i = 0; i < 8; ++i) {
        const int row = r0 + 16 * i, m = mbase + row;
        if (row < 2 || m >= MTOK) continue;
        const Tok k = tokinfo(m);
        const F8 cur = ld32(T + row * 128 + c8);
        F8 prev;
        if (k.t >= 1) prev = ld32(T + (row - 1) * 128 + c8);
        else prev = (k.seq >= 8 && n < RWP) ? ld32(p.in[I_SSH] + (size_t)(k.seq - 8) * RWP + n) : zero8();
        F8 xs;
        xs.a = cur.a + (prev.a - cur.a) * muv.a;
        xs.b = cur.b + (prev.b - cur.b) * muv.b;
        if (n < 3072) st16(PB + (size_t)m * 3072 + n, xs);
        else {
          const int q = n - 3072;
          if (q < LAW) {
            F8 v;
            if (q < 64) { v.a = f32x4{tanh_(xs.a.x), tanh_(xs.a.y), tanh_(xs.a.z), tanh_(xs.a.w)}; v.b = f32x4{tanh_(xs.b.x), tanh_(xs.b.y), tanh_(xs.b.z), tanh_(xs.b.w)}; }
            else if (q < 128) v = xs;
            else if (q < 288) { v.a = f32x4{sigm(xs.a.x), sigm(xs.a.y), sigm(xs.a.z), sigm(xs.a.w)}; v.b = f32x4{sigm(xs.b.x), sigm(xs.b.y), sigm(xs.b.z), sigm(xs.b.w)}; }
            else v = zero8();
            st16(LA + (size_t)m * LAW + q, v);
          }
        }
        if (n < RWP && k.t == k.T - 1) st32(p.out + O_SH + (size_t)k.seq * RWP + n, cur);
      }
      __syncthreads();
    }
  }
}

template <int CTRL> FI float dpp_mov(float v) { return __builtin_bit_cast(float, __builtin_amdgcn_update_dpp(0, __builtin_bit_cast(int, v), CTRL, 0xF, 0xF, true)); }
FI float row8_sum(float v) { v += dpp_mov<0xB1>(v); v += dpp_mov<0x4E>(v); v += dpp_mov<0x141>(v); return v; }
FI float row16_sum(float v) { v = row8_sum(v); v += dpp_mov<0x140>(v); return v; }

constexpr size_t OUT_Y_BYTES = 34865152;
constexpr size_t WS_YS = WS_END + 65536;
constexpr size_t WS_RK = WS_YS + 1048576;
FI h16* yrow(const Params& p, int m) {
  return m < NPTOK ? (h16*)((char*)p.out + OUT_Y_BYTES) + (size_t)m * DM : (h16*)(p.ws + WS_YS) + (size_t)(m - NPTOK) * DM;
}

FI void phaseA(const Params& p, char* lds) {
  const int tid = threadIdx.x, lane = tid & 63, wave = tid >> 6, wr = wave >> 1, wc = wave & 1;
  const h16* LA = (const h16*)(p.ws + WS_E);
  h16* DA = (h16*)p.out;
  h16* AA = (h16*)(p.ws + WS_D);
  for (int it = blockIdx.x; it < 16 * NMT; it += gridDim.x) {
    const int j = it / NMT, mt = it - j * NMT;
    const int mbase = mt * 128, which = j >> 3, n0 = (j & 7) * 128;
    f32x4 acc[4][4];
    zero_acc(acc);
    if (which == 0) mainloop(acc, LA, LAW, mbase, (const h16*)(p.ws + WS_WLD) + (size_t)n0 * 64, 64, 64, lds);
    else mainloop(acc, LA + 64, LAW, mbase, (const h16*)(p.ws + WS_WLA) + (size_t)n0 * 64, 64, 64, lds);
    h16* dst = which == 0 ? DA : AA;
    stage_acc(acc, (float*)lds);
    __syncthreads();
    if (which == 0) {
      const float* T = (const float*)lds;
      const int ci = tid >> 5, cq = (tid & 31) * 4, n = n0 + cq;
      const f32x4 bias = *(const f32x4*)(p.in[I_W0] + n);
      f32x4 run = {1.f, 1.f, 1.f, 1.f};
#pragma unroll 1
      for (int rr = 0; rr < 16; ++rr) {
        const int row = ci * 16 + rr, m = mbase + row;
        if (m >= NPTOK && (m & 3) == 0) run = f32x4{1.f, 1.f, 1.f, 1.f};
        const f32x4 x = *(const f32x4*)(T + row * 128 + cq) + bias;
        run = run * f32x4{__expf(-0.60653066f * sigm(x.x)), __expf(-0.60653066f * sigm(x.y)), __expf(-0.60653066f * sigm(x.z)), __expf(-0.60653066f * sigm(x.w))};
        h16x4 h; h[0] = (h16)run.x; h[1] = (h16)run.y; h[2] = (h16)run.z; h[3] = (h16)run.w;
        *(h16x4*)(dst + (size_t)m * DM + n) = h;
      }
    } else {
      const float* T = (const float*)lds;
      const int c8 = (tid & 15) * 8, r0 = tid >> 4, n = n0 + c8;
      const float* w0p = p.in[I_W0]; const float* a0p = p.in[I_A0];
      const F8 bias = ld32((which == 0 ? w0p : a0p) + n);
#pragma unroll 1
      for (int i = 0; i < 8; ++i) {
        const int row = r0 + 16 * i, m = mbase + row;
        const F8 a = ld32(T + row * 128 + c8);
        const f32x4 xa = a.a + bias.a, xb = a.b + bias.b;
        F8 o;
        o.a = f32x4{sigm(xa.x), sigm(xa.y), sigm(xa.z), sigm(xa.w)}; o.b = f32x4{sigm(xb.x), sigm(xb.y), sigm(xb.z), sigm(xb.w)};
        if (which == 0) {
          o.a = f32x4{__expf(-0.60653066f * o.a.x), __expf(-0.60653066f * o.a.y), __expf(-0.60653066f * o.a.z), __expf(-0.60653066f * o.a.w)};
          o.b = f32x4{__expf(-0.60653066f * o.b.x), __expf(-0.60653066f * o.b.y), __expf(-0.60653066f * o.b.z), __expf(-0.60653066f * o.b.w)};
        }
        st16(dst + (size_t)m * DM + n, o);
      }
    }
    __syncthreads();
  }
}

FI void scan_unit(const Params& p, float* sm, int seq, int head, int half) {
  const int tid = threadIdx.x;
  const int T = seq < 8 ? TPR : 4;
  const int mseq = seq < 8 ? seq * TPR : NPTOK + (seq - 8) * 4;
  const h16* PB = (const h16*)(p.ws + WS_B);
  const h16* DA = (const h16*)p.out;
  const h16* AA = (const h16*)(p.ws + WS_D);
  const int rp = tid >> 4, cb = tid & 15;
  const int chp = head * 64 + cb * 4;
  const int row0 = half * 32 + rp * 2;
  f32x2 S0a, S0b, S1a, S1b;
  if (seq >= 8) {
    const float* sp = p.in[I_SWKV] + ((size_t)(seq - 8) * 16 + head) * 4096 + row0 * 64 + cb * 4;
    const f32x4 u = *(const f32x4*)sp, w = *(const f32x4*)(sp + 64);
    S0a = f32x2{u.x, u.y}; S0b = f32x2{u.z, u.w}; S1a = f32x2{w.x, w.y}; S1b = f32x2{w.z, w.w};
  } else { S0a = f32x2{0.f, 0.f}; S0b = S0a; S1a = S0a; S1b = S0a; }
  const f32x4 kkc = *(const f32x4*)(p.in[I_KK] + chp), kac = *(const f32x4*)(p.in[I_KA] + chp), rkc = *(const f32x4*)(p.in[I_RK] + chp);
  float* RKo = (float*)(p.ws + WS_RK);
  const int nch = (T + 15) >> 4;
  h16x2* YP = (h16x2*)(sm + 12288);
  h16x4 Apr, Apk, Apv, Apd, Apa, Ape, Bpr, Bpk, Bpv, Bpd, Bpa, Bpe, Cpr, Cpk, Cpv, Cpd, Cpa, Cpe;
#define SC_LOAD(P, T0) do { int mp = (T0) + rp; if (mp > T - 1) mp = T - 1; const size_t mm = (size_t)(mseq + mp); \
    const h16* pp = PB + mm * 3072 + chp; P##pr = *(const h16x4*)pp; P##pk = *(const h16x4*)(pp + 1024); P##pv = *(const h16x4*)(pp + 2048); \
    P##pd = *(const h16x4*)(DA + mm * DM + chp); P##pa = *(const h16x4*)(AA + mm * DM + chp); \
    P##pe = *(const h16x4*)(DA + (mm - (rp > 0 ? 1 : 0)) * DM + chp); } while (0)
#define SC_PREP(P, BUF, T0) do { float* bb = sm + (BUF) * 6144; \
    const f32x4 r4 = {(float)P##pr[0], (float)P##pr[1], (float)P##pr[2], (float)P##pr[3]}; \
    const f32x4 k4 = {(float)P##pk[0], (float)P##pk[1], (float)P##pk[2], (float)P##pk[3]}; \
    const f32x4 v4 = {(float)P##pv[0], (float)P##pv[1], (float)P##pv[2], (float)P##pv[3]}; \
    const f32x4 lam = {(float)P##pd[0], (float)P##pd[1], (float)P##pd[2], (float)P##pd[3]}; \
    f32x4 lam1 = {(float)P##pe[0], (float)P##pe[1], (float)P##pe[2], (float)P##pe[3]}; \
    if (rp == 0) lam1 = f32x4{1.f, 1.f, 1.f, 1.f}; \
    const f32x4 linv = f32x4{__builtin_amdgcn_rcpf(lam.x), __builtin_amdgcn_rcpf(lam.y), __builtin_amdgcn_rcpf(lam.z), __builtin_amdgcn_rcpf(lam.w)}; \
    const f32x4 a4 = {(float)P##pa[0], (float)P##pa[1], (float)P##pa[2], (float)P##pa[3]}; \
    const f32x4 kkv = k4 * kkc; \
    const float ss = row16_sum(kkv.x * kkv.x + kkv.y * kkv.y + kkv.z * kkv.z + kkv.w * kkv.w); \
    const f32x4 kk = kkv * __builtin_amdgcn_rcpf(fmaxf(__builtin_amdgcn_sqrtf(ss), 1e-12f)); \
    const int o = rp * 64 + cb * 4; \
      \
    const f32x4 kp_ = k4 * (1.f + (a4 - 1.f) * kac); \
    { const f32x4 rk4_ = r4 * kp_ * rkc; const float rks_ = row16_sum((rk4_.x + rk4_.y) + (rk4_.z + rk4_.w)); \
      if (half == 0 && cb == 0 && (T0) + rp < T) RKo[(size_t)(mseq + (T0) + rp) * 16 + head] = rks_; } \
    *(f32x4*)(bb + o) = r4 * lam; *(f32x4*)(bb + 1024 + o) = lam; *(f32x4*)(bb + 2048 + o) = kp_ * linv; \
    *(f32x4*)(bb + 3072 + o) = v4; *(f32x4*)(bb + 4096 + o) = -kk * lam1; *(f32x4*)(bb + 5120 + o) = kk * a4 * linv; } while (0)
#define ST_LOAD(X, TT) do { const float* q_ = bb + (TT) * 64 + cb * 4; \
    X##a = *(const f32x4*)(q_ + 4096); X##b = *(const f32x4*)(q_ + 5120); \
    X##k = *(const f32x4*)(q_ + 2048); X##r = *(const f32x4*)q_; X##v = *(const f32x2*)(bb + 3072 + (TT) * 64 + row0); } while (0)
#define LO(v) f32x2{(v).x, (v).y}
#define HI(v) f32x2{(v).z, (v).w}
#define ST_COMP(X, TT) do { \
    f32x2 s0_ = S0a * LO(X##a), s1_ = S1a * LO(X##a); s0_ = S0b * HI(X##a) + s0_; s1_ = S1b * HI(X##a) + s1_; \
    const f32x2 v0_ = {X##v.x, X##v.x}, v1_ = {X##v.y, X##v.y}; \
    const f32x2 u0a_ = LO(X##k) * v0_ + S0a, u0b_ = HI(X##k) * v0_ + S0b; \
    const f32x2 u1a_ = LO(X##k) * v1_ + S1a, u1b_ = HI(X##k) * v1_ + S1b; \
    const float sa0_ = row16_sum(s0_.x + s0_.y), sa1_ = row16_sum(s1_.x + s1_.y); \
    const f32x2 q0_ = {sa0_, sa0_}, q1_ = {sa1_, sa1_}; \
    S0a = LO(X##b) * q0_ + u0a_; S0b = HI(X##b) * q0_ + u0b_; S1a = LO(X##b) * q1_ + u1a_; S1b = HI(X##b) * q1_ + u1b_; \
    f32x2 y0_ = S0a * LO(X##r), y1_ = S1a * LO(X##r); y0_ = S0b * HI(X##r) + y0_; y1_ = S1b * HI(X##r) + y1_; \
    { h16x2 yp_; yp_[0] = (h16)(y0_.x + y0_.y); yp_[1] = (h16)(y1_.x + y1_.y); YP[(TT) * 256 + tid] = yp_; } } while (0)
#define SC_BODY(c, LSET, PSET) do { \
    const int t0 = (c) * 16; \
    const int nt = (T - t0) < 16 ? (T - t0) : 16;       \
    const float* bb = sm + ((c) & 1) * 6144; \
    if ((c) + 3 < nch) SC_LOAD(LSET, t0 + 48); \
    { \
      f32x4 Aa, Ab, Ak, Ar; f32x2 Av; \
      f32x4 Ba, Bb, Bk, Br; f32x2 Bv; \
      ST_LOAD(A, 0); \
      for (int tt = 0; tt < nt; tt += 2) { \
        ST_LOAD(B, tt + 1); \
        ST_COMP(A, tt); \
        const int tn = tt + 2 < nt ? tt + 2 : tt; \
        ST_LOAD(A, tn); \
        ST_COMP(B, tt + 1); \
      } \
    } \
    {   \
      const f32x4 ll_ = *(const f32x4*)(bb + 1024 + (nt - 1) * 64 + cb * 4); \
      S0a = S0a * LO(ll_); S0b = S0b * HI(ll_); S1a = S1a * LO(ll_); S1b = S1b * HI(ll_); } \
    __syncthreads(); \
    if (rp < nt) {     \
      const uint4* q_ = (const uint4*)(YP + rp * 256 + cb * 16); \
      float a0_ = 0.f, a1_ = 0.f; \
      _Pragma("unroll") for (int e_ = 0; e_ < 4; ++e_) { \
        const uint4 w_ = q_[e_]; \
        const h16x2 p0_ = __builtin_bit_cast(h16x2, w_.x), p1_ = __builtin_bit_cast(h16x2, w_.y), p2_ = __builtin_bit_cast(h16x2, w_.z), p3_ = __builtin_bit_cast(h16x2, w_.w); \
        a0_ += ((float)p0_[0] + (float)p1_[0]) + ((float)p2_[0] + (float)p3_[0]); \
        a1_ += ((float)p0_[1] + (float)p1_[1]) + ((float)p2_[1] + (float)p3_[1]); \
      } \
      h16x2 yh; yh[0] = (h16)a0_; yh[1] = (h16)a1_; \
      *(h16x2*)(yrow(p, mseq + t0 + rp) + head * 64 + half * 32 + cb * 2) = yh; \
    } \
    if ((c) + 1 < nch) SC_PREP(PSET, ((c) + 1) & 1, t0 + 16);     \
    __syncthreads(); } while (0)
  SC_LOAD(A, 0);
  if (nch > 1) { SC_LOAD(B, 16); SC_LOAD(C, 32); }
  SC_PREP(A, 0, 0);
  __syncthreads();
  for (int c = 0; c < nch; c += 3) {
    SC_BODY(c, A, B);
    if (c + 1 < nch) SC_BODY(c + 1, B, C);
    if (c + 2 < nch) SC_BODY(c + 2, C, A);
  }
#undef SC_BODY
  {
    float* op = p.out + O_WKV + ((size_t)seq * 16 + head) * 4096 + row0 * 64 + cb * 4;
    *(f32x4*)op = f32x4{S0a.x, S0a.y, S0b.x, S0b.y}; *(f32x4*)(op + 64) = f32x4{S1a.x, S1a.y, S1b.x, S1b.y};
  }
  __syncthreads();
#undef SC_LOAD
#undef SC_PREP
#undef ST_LOAD
#undef ST_COMP
#undef LO
#undef HI
}

FI void phase3(const Params& p, char* lds) {
  float* sm = (float*)lds;
  const int G = gridDim.x, b = blockIdx.x;
  for (int u = b; u < 256; u += G) scan_unit(p, sm, u >> 5, (u >> 1) & 15, u & 1);
  if (G > 256) {
    if (b >= 256) {
      for (int u = b - 256; u < 4096; u += G - 256) scan_unit(p, sm, 8 + (u >> 5), (u >> 1) & 15, u & 1);
      for (int it = 2144 + (b - 256); it < 5024; it += G - 256) transpose_item(p, sm, it);
    }
  }
  else {
    for (int u = b; u < 4096; u += G) scan_unit(p, sm, 8 + (u >> 5), (u >> 1) & 15, u & 1);
    for (int it = 2144 + b; it < 5024; it += G) transpose_item(p, sm, it);
  }
}

FI void phase3b(const Params& p, char* lds) {
  const int tid = threadIdx.x;
  const h16* LA = (const h16*)(p.ws + WS_E);
  const h16* PB = (const h16*)(p.ws + WS_B);
  h16* AZ = (h16*)(p.ws + WS_D);
  const float* RK = (const float*)(p.ws + WS_RK);
  h16* TG = (h16*)lds;
  const int c8 = (tid & 15) * 8, r0 = tid >> 4;
  for (int it = blockIdx.x; it < 8 * NMT; it += gridDim.x) {
    const int j = it / NMT, mt = it - j * NMT;
    const int mbase = mt * 128, n0 = j * 128;
    {
      f32x4 acc[4][4];
      zero_acc(acc);
      mainloop(acc, LA + 128, LAW, mbase, (const h16*)(p.ws + WS_WLG) + (size_t)n0 * 192, 192, 192, lds);
      stage16(acc, TG);
    }
    __syncthreads();
    const int ch = n0 + c8;
    const F8 lg = ld32(p.in[I_LNG] + ch), lb = ld32(p.in[I_LNB] + ch);
#pragma unroll 1
    for (int i = 0; i < 8; ++i) {
      const int row = r0 + 16 * i, m = mbase + row;
      const F8 y = ld16(yrow(p, m) + ch);
      const F8 v = ld16(PB + (size_t)m * 3072 + 2048 + ch);
      const F8 g = ld16(TG + row * 128 + c8);
      const float rk = RK[(size_t)m * 16 + (ch >> 6)];
      const f32x4 ys = y.a + y.b;
      const float mean = row8_sum((ys.x + ys.y) + (ys.z + ys.w)) * (1.f / 64.f);
      F8 d; d.a = y.a - mean; d.b = y.b - mean;
      const f32x4 d2 = d.a * d.a + d.b * d.b;
      const float var = row8_sum((d2.x + d2.y) + (d2.z + d2.w)) * (1.f / 64.f);
      const float rs = rsqrtf(var + 64e-5f);
      F8 z;
      z.a = (d.a * rs * lg.a + lb.a + v.a * rk) * g.a;
      z.b = (d.b * rs * lg.b + lb.b + v.b * rk) * g.b;
      st16(AZ + (size_t)m * DM + ch, z);
    }
    __syncthreads();
  }
}

FI void phase4(const Params& p, char* lds) {
  const int tid = threadIdx.x;
  const h16* XN = (const h16*)(p.ws + WS_A);
  const h16* ZA = (const h16*)(p.ws + WS_D);
  const h16* ZB = (const h16*)(p.ws + WS_C);
  const h16* WinT = (const h16*)(p.ws + WS_WIN);
  const h16* WA = (const h16*)(p.ws + WS_WA);
  const h16* WB = (const h16*)(p.ws + WS_WB);
  h16* MG = (h16*)(p.ws + WS_B);
  h16* G2 = (h16*)(p.ws + WS_B + OUT_Y_BYTES);
  h16* T0 = (h16*)lds; h16* T1 = T0 + 16384;
  const int c8 = (tid & 15) * 8, r0 = tid >> 4;
  for (int it = blockIdx.x; it < 8 * NMT; it += gridDim.x) {
    const int j = it / NMT, mt = it - j * NMT;
    const int mbase = mt * 128, n0 = j * 128, n = n0 + c8;
    {
      f32x4 acc[4][4], acc2[4][4];
      zero_acc(acc); zero_acc(acc2);
      mainloop2(acc, acc2, XN, DM, mbase, WinT + (size_t)(6528 + n0) * DM, WinT + (size_t)(7552 + n0) * DM, DM, DM, lds);
      stage16(acc, T0); stage16(acc2, T1);
    }
    __syncthreads();
    {
      const F8 ba = ld32(p.in[I_BG] + n), bb = ld32(p.in[I_BG] + 1024 + n);
#pragma unroll 1
      for (int i = 0; i < 8; ++i) {
        const int row = r0 + 16 * i; const size_t o = (size_t)(mbase + row) * DM + n;
        const F8 a = ld16(T0 + row * 128 + c8), b = ld16(T1 + row * 128 + c8);
        const f32x4 xa = a.a + ba.a, xb = a.b + ba.b, ya = b.a + bb.a, yb = b.b + bb.b;
        F8 ga, gb;
        ga.a = f32x4{sigm(xa.x), sigm(xa.y), sigm(xa.z), sigm(xa.w)}; ga.b = f32x4{sigm(xb.x), sigm(xb.y), sigm(xb.z), sigm(xb.w)};
        gb.a = f32x4{sigm(ya.x), sigm(ya.y), sigm(ya.z), sigm(ya.w)}; gb.b = f32x4{sigm(yb.x), sigm(yb.y), sigm(yb.z), sigm(yb.w)};
        st16(MG + o, ga); st16(G2 + o, gb);
      }
    }
    __syncthreads();
  }
  for (int it = blockIdx.x; it < 8 * NMT; it += gridDim.x) {
    const int j = it / NMT, mt = it - j * NMT;
    const int mbase = mt * 128, n0 = j * 128, n = n0 + c8;
    {
      uint32_t pk[4][4][2];
#pragma unroll 1
      for (int pass = 0; pass < 2; ++pass) {
        f32x4 acc[4][4];
        zero_acc(acc);
        mainloop(acc, pass == 0 ? ZA : ZB, DM, mbase, (pass == 0 ? WA : WB) + (size_t)n0 * DM, DM, DM, lds);
        if (pass == 0) pack_acc(acc, pk);
        else { stage16_pk(pk, T0); stage16(acc, T1); }
      }
    }
    __syncthreads();
#pragma unroll 1
    for (int i = 0; i < 8; ++i) {
      const int row = r0 + 16 * i; const size_t o = (size_t)(mbase + row) * DM + n;
      const h16x8 oa = *(const h16x8*)(T0 + row * 128 + c8), ob = *(const h16x8*)(T1 + row * 128 + c8);
      const h16x8 ga = *(const h16x8*)(MG + o), gb = *(const h16x8*)(G2 + o);
      *(h16x8*)(MG + o) = ga * oa + gb * ob;
    }
    __syncthreads();
  }
}

FI void phase5(const Params& p, char* lds) {
  const int tid = threadIdx.x, lane = tid & 63, wave = tid >> 6, wr = wave >> 1, wc = wave & 1;
  const h16* MG = (const h16*)(p.ws + WS_B);
  const h16* WO = (const h16*)(p.ws + WS_WO);
  h16* X1 = (h16*)(p.ws + WS_A);
  for (int it = blockIdx.x; it < 8 * NMT; it += gridDim.x) {
    const int j = it / NMT, mt = it - j * NMT;
    const int mbase = mt * 128, n0 = j * 128;
    f32x4 acc[4][4];
    zero_acc(acc);
    mainloop(acc, MG, DM, mbase, WO + (size_t)n0 * DM, DM, DM, lds);
    stage_acc(acc, (float*)lds);
    __syncthreads();
    {
      const float* T = (const float*)lds;
      const int c8 = (tid & 15) * 8, r0 = tid >> 4, n = n0 + c8;
#pragma unroll 1
      for (int i = 0; i < 8; ++i) {
        const int row = r0 + 16 * i, m = mbase + row;
        const F8 a = ld32(T + row * 128 + c8), x = ld32(xrow(p, m) + n);
        F8 o; o.a = x.a + a.a; o.b = x.b + a.b;
        st16(X1 + (size_t)m * DM + n, o);
      }
    }
    __syncthreads();
  }
}

FI void phase7(const Params& p, char* lds) {
  const int tid = threadIdx.x;
  const h16* XN2 = (const h16*)(p.ws + WS_D);
  const h16* WUP = (const h16*)(p.ws + WS_WUP);
  h16* HH = (h16*)(p.ws + WS_B);
  h16* TG = (h16*)lds; h16* TV = TG + 16384;
  const int c8 = (tid & 15) * 8, r0 = tid >> 4;
  for (int it = blockIdx.x; it < 22 * NMT_H; it += gridDim.x) {
    const int j = it / NMT_H, mt = it - j * NMT_H;
    const int mbase = mt * 126 - 2, n0 = j * 128;
    {
      f32x4 acc[4][4], acc2[4][4];
      zero_acc(acc); zero_acc(acc2);
      mainloop2(acc, acc2, XN2, DM, mbase, WUP + (size_t)n0 * DM, WUP + (size_t)(DFF + n0) * DM, DM, DM, lds);
      stage16(acc, TG); stage16(acc2, TV);
    }
    __syncthreads();
    const int cgc = n0 + c8, cvc = DFF + n0 + c8;
    const float* cw = p.in[I_CFFN];
    const h16x8 g0 = cvth(ld32(cw + cgc)), g1 = cvth(ld32(cw + 5632 + cgc)), g2 = cvth(ld32(cw + 11264 + cgc));
    const h16x8 v0 = cvth(ld32(cw + cvc)), v1 = cvth(ld32(cw + 5632 + cvc)), v2 = cvth(ld32(cw + 11264 + cvc));
#pragma unroll 1
    for (int i = 0; i < 8; ++i) {
      const int row = r0 + 16 * i, m = mbase + row;
      if (row < 2 || m >= MTOK) continue;
      const Tok k = tokinfo(m);
      const h16x8 gc = *(const h16x8*)(TG + row * 128 + c8), vc = *(const h16x8*)(TV + row * 128 + c8);
      h16x8 gp1, gp2, vp1, vp2;
      const float* st = p.in[I_SFFN] + (size_t)(k.seq - 8) * 11264;
      conv_prev16(TG, row, c8, k, st + cgc, 5632, gp1, gp2);
      conv_prev16(TV, row, c8, k, st + cvc, 5632, vp1, vp2);
      const h16x8 cgh = g0 * gp2 + g1 * gp1 + g2 * gc;
      const h16x8 cvh = v0 * vp2 + v1 * vp1 + v2 * vc;
      const F8 cg_ = cvtf(cgh);
      F8 sl;
      sl.a = f32x4{cg_.a.x * sigm(cg_.a.x), cg_.a.y * sigm(cg_.a.y), cg_.a.z * sigm(cg_.a.z), cg_.a.w * sigm(cg_.a.w)};
      sl.b = f32x4{cg_.b.x * sigm(cg_.b.x), cg_.b.y * sigm(cg_.b.y), cg_.b.z * sigm(cg_.b.z), cg_.b.w * sigm(cg_.b.w)};
      *(h16x8*)(HH + (size_t)m * DFF + n0 + c8) = cvth(sl) * cvh;
      if (k.t >= k.T - 2) {
        float* fo = p.out + O_FFN + (size_t)k.seq * 11264 + (k.t - (k.T - 2)) * 5632;
        st32(fo + cgc, cvtf(gc)); st32(fo + cvc, cvtf(vc));
      }
    }
    __syncthreads();
  }
}

FI void phase8(const Params& p, char* lds) {
  const int tid = threadIdx.x, lane = tid & 63, wave = tid >> 6, wr = wave >> 1, wc = wave & 1;
  const h16* HH = (const h16*)(p.ws + WS_B);
  const h16* WDN = (const h16*)(p.ws + WS_WDN);
  h16* X1 = (h16*)(p.ws + WS_A);
  for (int it = blockIdx.x; it < 8 * NMT; it += gridDim.x) {
    const int j = it / NMT, mt = it - j * NMT;
    const int mbase = mt * 128, n0 = j * 128;
    f32x4 acc[4][4];
    zero_acc(acc);
    mainloop(acc, HH, DFF, mbase, WDN + (size_t)n0 * DFF, DFF, DFF, lds);
    stage_acc(acc, (float*)lds);
    __syncthreads();
    {
      const float* T = (const float*)lds;
      const int c8 = (tid & 15) * 8, r0 = tid >> 4, n = n0 + c8;
#pragma unroll 1
      for (int i = 0; i < 8; ++i) {
        const int row = r0 + 16 * i, m = mbase + row;
        h16* q = X1 + (size_t)m * DM + n;
        const F8 a = ld32(T + row * 128 + c8), x = ld16(q);
        F8 o; o.a = x.a + a.a; o.b = x.b + a.b;
        st16(q, o);
      }
    }
    __syncthreads();
  }
}

constexpr int NPHASE = 11;

#define XB_TMO      128
#define XB_XCNT(j)  (256  + 64 * (j))
#define XB_XSUB(j)  (1280 + 64 * (j))
#define XB_XGEN(j)  (2304 + 64 * (j))
#define XB_TOP      3328
#define XB_TOPGEN   3392
#define XCD_BAR_WORDS 3456
#define XB_SPIN_CAP (1u << 18)
FI unsigned xb_ld(unsigned* p)              { return __hip_atomic_load(p, __ATOMIC_RELAXED, __HIP_MEMORY_SCOPE_AGENT); }
FI unsigned xb_add(unsigned* p, unsigned v) { return __hip_atomic_fetch_add(p, v, __ATOMIC_RELAXED, __HIP_MEMORY_SCOPE_AGENT); }
FI unsigned xb_xcc_id() { return (unsigned)__builtin_amdgcn_s_getreg((3 << 11) | 20) & 0xFu; }
#define XB_SPIN(cond, bar) do { unsigned _sp = 0; while (cond) { __builtin_amdgcn_s_sleep(1); \
    if ((++_sp & 255u) == 0u) { if (xb_ld(&(bar)[XB_TMO])) break; if (_sp > XB_SPIN_CAP) { atomicAdd(&(bar)[XB_TMO], 1u); break; } } } } while (0)
struct XcdBarrier { unsigned* bar; unsigned x; volatile unsigned* st; };
FI XcdBarrier xcd_barrier_post(unsigned* bar, volatile unsigned* st) {
  XcdBarrier b; b.bar = bar; b.x = xb_xcc_id(); b.st = st;
  if (threadIdx.x == 0) (void)xb_add(&bar[XB_XCNT(b.x)], 1u);
  return b;
}
FI void xcd_barrier_complete(unsigned* bar, unsigned x, unsigned& nloc, unsigned& nx) {
  const unsigned G = gridDim.x * gridDim.y * gridDim.z;
  unsigned sum, cnt, mine, sp = 0u;
  for (;;) {
    sum = 0u; cnt = 0u; mine = 0u;
#pragma unroll
    for (unsigned j = 0; j < 16; ++j) { const unsigned c = xb_ld(&bar[XB_XCNT(j)]); sum += c; cnt += (c > 0u) ? 1u : 0u; mine = (j == x) ? c : mine; }
    if (sum == G) break;
    __builtin_amdgcn_s_sleep(1);
    if ((++sp & 255u) == 0u) { if (xb_ld(&bar[XB_TMO])) break; if (sp > XB_SPIN_CAP) { atomicAdd(&bar[XB_TMO], 1u); break; } }
  }
  nloc = mine > 0u ? mine : 1u; nx = cnt > 0u ? cnt : 1u;
}
FI void xcd_barrier(const XcdBarrier& b) {
  asm volatile("s_waitcnt vmcnt(0)" ::: "memory");
  __syncthreads();
  if (threadIdx.x == 0) {
    unsigned* bar = b.bar;
    __builtin_amdgcn_s_waitcnt(0);
    unsigned nloc = b.st[0], nx = b.st[1];
    if (nloc == 0u) { xcd_barrier_complete(bar, b.x, nloc, nx); b.st[0] = nloc; b.st[1] = nx; }
    const unsigned old = xb_add(&bar[XB_XSUB(b.x)], 1u);
    const unsigned gen = old / nloc;
    if (old + 1u == (gen + 1u) * nloc) {
      __builtin_amdgcn_fence(__ATOMIC_RELEASE, "agent");
      asm volatile("s_waitcnt vmcnt(0)" ::: "memory");
      const unsigned og = xb_add(&bar[XB_TOP], 1u);
      const unsigned tg = og / nx;
      if (og + 1u == (tg + 1u) * nx) xb_add(&bar[XB_TOPGEN], 1u);
      else XB_SPIN(xb_ld(&bar[XB_TOPGEN]) == tg, bar);
      __builtin_amdgcn_fence(__ATOMIC_ACQUIRE, "agent");
      xb_add(&bar[XB_XGEN(b.x)], 1u);
      asm volatile("s_waitcnt vmcnt(0)" ::: "memory");
    } else {
      XB_SPIN(xb_ld(&bar[XB_XGEN(b.x)]) == gen, bar);
      __builtin_amdgcn_fence(__ATOMIC_ACQUIRE, "agent");
      asm volatile("s_waitcnt vmcnt(0)" ::: "memory");
    }
  }
  __syncthreads();
}

template <int PH> FI void run_phase(const Params& p, char* lds) {
  if (PH == 0) phase0(p, lds);
  if (PH == 1) phase1(p, lds);
  if (PH == 2) phaseA(p, lds);
  if (PH == 3) phase3(p, lds);
  if (PH == 4) phase3b(p, lds);
  if (PH == 5) phase4(p, lds);
  if (PH == 6) phase5(p, lds);
  if (PH == 7) rms_rows(p, 1, (const float*)(p.ws + WS_A), p.in[I_N2G], (h16*)(p.ws + WS_D), blockIdx.x * 4 + (threadIdx.x >> 6), gridDim.x * 4);
  if (PH == 8) phase7(p, lds);
  if (PH == 9) phase8(p, lds);
  if (PH == 10) rms_rows(p, 2, (const float*)(p.ws + WS_A), p.in[I_FNG], nullptr, blockIdx.x * 4 + (threadIdx.x >> 6), gridDim.x * 4);
}

template <int PH> __global__ void __launch_bounds__(256, 1) mega_one(Params p) {
  __shared__ __attribute__((aligned(16))) char lds[65536];
  run_phase<PH>(p, lds);
}

#if N_LAUNCH_MODE == 1
__global__ void __launch_bounds__(256, 2) mega(Params p) {
  __shared__ __attribute__((aligned(16))) char lds[65536 + 16];
  volatile unsigned* st = (volatile unsigned*)(lds + 65536);
  if (threadIdx.x < 4) st[threadIdx.x] = 0u;
  __syncthreads();
  if (p.ph_lo < 0) cg::this_grid().sync();
  XcdBarrier xb = xcd_barrier_post((unsigned*)(p.ws + WS_END), st);
  run_phase<0>(p, lds); xcd_barrier(xb);
  run_phase<1>(p, lds); xcd_barrier(xb);
  run_phase<2>(p, lds); xcd_barrier(xb);
  run_phase<3>(p, lds); xcd_barrier(xb);
  run_phase<4>(p, lds); xcd_barrier(xb);
  run_phase<5>(p, lds); xcd_barrier(xb);
  run_phase<6>(p, lds); xcd_barrier(xb);
  run_phase<7>(p, lds); xcd_barrier(xb);
  run_phase<8>(p, lds); xcd_barrier(xb);
  run_phase<9>(p, lds); xcd_barrier(xb);
  run_phase<10>(p, lds);
}
#endif

extern "C" void kernel_launch(void* const* d_in, const int* in_sizes, int n_in, void* d_out, int out_size,
                              void* d_ws, size_t ws_size, hipStream_t stream) {
  static int grid = 0;
  if (!grid) {
    int dev = 0, cus = 0, per_cu = 0;
    (void)hipGetDevice(&dev);
    (void)hipDeviceGetAttribute(&cus, hipDeviceAttributeMultiprocessorCount, dev);
#if N_LAUNCH_MODE == 1
    (void)hipOccupancyMaxActiveBlocksPerMultiprocessor(&per_cu, mega, 256, 0);
#else
    per_cu = 2;
#endif
    if (per_cu < 1) per_cu = 1;
    if (per_cu > 2) per_cu = 2;
    grid = cus * per_cu;
    if (ws_size < WS_RK + 1179648) fprintf(stderr, "workspace too small: %zu < %zu\n", ws_size, (size_t)WS_END);
  }
  Params p{};
  for (int i = 0; i < 30; ++i) p.in[i] = (const float*)d_in[i];
  p.out = (float*)d_out;
  p.ws = (char*)d_ws;
#if N_LAUNCH_MODE == 1
  p.ph_lo = 0; p.ph_hi = NPHASE;
  (void)hipMemsetAsync((char*)d_ws + WS_END, 0, XCD_BAR_WORDS * 4, stream);
  void* args[] = {&p};
  hipError_t e = hipLaunchCooperativeKernel((void*)mega, dim3(grid), dim3(256), args, 0, stream);
  if (e != hipSuccess) fprintf(stderr, "cooperative launch failed: %s (grid %d)\n", hipGetErrorString(e), grid);
#else
  p.ph_lo = 0; p.ph_hi = NPHASE;
  hipLaunchKernelGGL(mega_one<0>, dim3(grid), dim3(256), 0, stream, p);
  hipLaunchKernelGGL(mega_one<1>, dim3(grid), dim3(256), 0, stream, p);
  hipLaunchKernelGGL(mega_one<2>, dim3(grid), dim3(256), 0, stream, p);
  hipLaunchKernelGGL(mega_one<3>, dim3(grid), dim3(256), 0, stream, p);
  hipLaunchKernelGGL(mega_one<4>, dim3(grid), dim3(256), 0, stream, p);
  hipLaunchKernelGGL(mega_one<5>, dim3(grid), dim3(256), 0, stream, p);
  hipLaunchKernelGGL(mega_one<6>, dim3(grid), dim3(256), 0, stream, p);
  hipLaunchKernelGGL(mega_one<7>, dim3(grid), dim3(256), 0, stream, p);
  hipLaunchKernelGGL(mega_one<8>, dim3(grid), dim3(256), 0, stream, p);
  hipLaunchKernelGGL(mega_one<9>, dim3(grid), dim3(256), 0, stream, p);
  hipLaunchKernelGGL(mega_one<10>, dim3(grid), dim3(256), 0, stream, p);
#endif
}
```

```cpp
#include <hip/hip_runtime.h>
#include <hip/hip_cooperative_groups.h>
#include <stdint.h>
#include <stdio.h>
namespace cg = cooperative_groups;

#ifndef N_LAUNCH_MODE
#define N_LAUNCH_MODE 1
#endif

typedef _Float16 h16;
typedef _Float16 h16x8 __attribute__((ext_vector_type(8)));
typedef _Float16 h16x4 __attribute__((ext_vector_type(4)));
typedef float f32x16 __attribute__((ext_vector_type(16)));
typedef float f32x4 __attribute__((ext_vector_type(4)));
typedef float f32x2 __attribute__((ext_vector_type(2)));

#define FI __device__ __forceinline__

constexpr int DM = 1024;
constexpr int MTOK = 17024;
constexpr int TPR = 2064;
constexpr int NPTOK = 16512;
constexpr int RWP = 3360;
constexpr int PTOT = 8480;
constexpr int DFF = 2816;
constexpr int LAW = 320;
constexpr int NMT_H = 136;
constexpr int NMT = 133;

constexpr size_t O_YP = 0, O_YS = 16777216, O_WKV = 17301504, O_SH = 26214400, O_SC = 26671360, O_FFN = 26949888;

constexpr size_t WS_WIN = 0;
constexpr size_t WS_WA = 17563648, WS_WB = 19660800, WS_WO = 21757952;
constexpr size_t WS_WUP = 23855104, WS_WDN = 35389440;
constexpr size_t WS_WLD = 41156608, WS_WLA = 41287680, WS_WLG = 41418752;
constexpr size_t WS_B = 41811968;
constexpr size_t WS_A = 146407424;
constexpr size_t WS_C = 181272576;
constexpr size_t WS_D = 216137728;
constexpr size_t WS_E = 251002880;
constexpr size_t WS_END = 261898240;

struct Params {
  const float* in[30];
  float* out;
  char* ws;
  int ph_lo, ph_hi;
};

enum { I_XP = 0, I_XS, I_SWKV, I_SSH, I_SSC, I_SFFN, I_META, I_N1G, I_WIN, I_BG, I_MU, I_W0, I_WDEC, I_A0, I_WAAA,
       I_WGATE, I_KK, I_KA, I_RK, I_LNG, I_LNB, I_WBR, I_WBS, I_CSC, I_WOUT, I_N2G, I_WUP, I_CFFN, I_WDN, I_FNG };

FI float sigm(float x) { return __builtin_amdgcn_rcpf(1.f + __expf(-x)); }
FI float tanh_(float x) { return 1.f - 2.f * __builtin_amdgcn_rcpf(1.f + __expf(2.f * x)); }
FI float wave_sum(float v) {
#pragma unroll
  for (int o = 32; o; o >>= 1) v += __shfl_xor(v, o);
  return v;
}
FI float sum16(float v) {
#pragma unroll
  for (int o = 8; o; o >>= 1) v += __shfl_xor(v, o);
  return v;
}
FI float quad_sum(float v) {
  float t = __builtin_bit_cast(float, __builtin_amdgcn_update_dpp(0, __builtin_bit_cast(int, v), 0xB1, 0xF, 0xF, true));
  v += t;
  t = __builtin_bit_cast(float, __builtin_amdgcn_update_dpp(0, __builtin_bit_cast(int, v), 0x4E, 0xF, 0xF, true));
  return v + t;
}
struct Tok { int seq, t, T; };
FI Tok tokinfo(int m) {
  Tok k;
  if (m < NPTOK) { k.seq = m / TPR; k.t = m - k.seq * TPR; k.T = TPR; }
  else { int mm = m - NPTOK; k.seq = 8 + (mm >> 2); k.t = mm & 3; k.T = 4; }
  return k;
}
FI const float* xrow(const Params& p, int m) {
  if (m < NPTOK) {
    int s = m / TPR, t = m - s * TPR;
    return t < 16 ? p.in[I_META] + t * DM : p.in[I_XP] + ((size_t)s * 2048 + (t - 16)) * DM;
  }
  return p.in[I_XS] + (size_t)(m - NPTOK) * DM;
}

FI int swz(int row, int chunk) { return row * 128 + ((chunk ^ ((row >> 1) & 7)) << 4); }

FI void zero_acc(f32x4 (&acc)[4][4]) {
#pragma unroll
  for (int a = 0; a < 4; ++a)
#pragma unroll
    for (int b = 0; b < 4; ++b) acc[a][b] = f32x4{0.f, 0.f, 0.f, 0.f};
}

FI void mainloop(f32x4 (&acc)[4][4], const h16* __restrict__ A, int lda, int mbase,
                 const h16* __restrict__ BT, int ldb, int K, char* lds) {
  const int tid = threadIdx.x, lane = tid & 63, wave = tid >> 6, wr = wave >> 1, wc = wave & 1;
  uint32_t aoff[4], boff[4];
#pragma unroll
  for (int i = 0; i < 4; ++i) {
    const int row = wave * 32 + i * 8 + (lane >> 3);
    const int chunk = (lane & 7) ^ ((row >> 1) & 7);
    int m = mbase + row; m = m < 0 ? 0 : (m > MTOK - 1 ? MTOK - 1 : m);
    aoff[i] = (uint32_t)m * lda + chunk * 8;
    boff[i] = (uint32_t)row * ldb + chunk * 8;
  }
  const int ldsw = wave * 4096 + lane * 16;
#define ML_ISSUE(KT, BUF) do { _Pragma("unroll") for (int i = 0; i < 4; ++i) { \
    __builtin_amdgcn_global_load_lds((const unsigned*)(A + aoff[i] + (KT) * 64), (unsigned*)(lds + (BUF) * 32768 + ldsw + i * 1024), 16, 0, 0); \
    __builtin_amdgcn_global_load_lds((const unsigned*)(BT + boff[i] + (KT) * 64), (unsigned*)(lds + (BUF) * 32768 + 16384 + ldsw + i * 1024), 16, 0, 0); } } while (0)
  const int nk = K >> 6;
  const int rA0 = wr * 64 + (lane & 15), rB0 = wc * 64 + (lane & 15), hh = lane >> 4;
  ML_ISSUE(0, 0);
  for (int kt = 0; kt < nk; ++kt) {
    const int buf = kt & 1;
    asm volatile("s_waitcnt vmcnt(0)" ::: "memory");
    __syncthreads();
    if (kt + 1 < nk) ML_ISSUE(kt + 1, buf ^ 1);
    const char* la = lds + buf * 32768;
    const char* lb = la + 16384;
#pragma unroll
    for (int ks = 0; ks < 2; ++ks) {
      h16x8 a[4], b[4];
#pragma unroll
      for (int t = 0; t < 4; ++t) {
        a[t] = *(const h16x8*)(la + swz(rA0 + t * 16, ks * 4 + hh));
        b[t] = *(const h16x8*)(lb + swz(rB0 + t * 16, ks * 4 + hh));
      }
#pragma unroll
      for (int ti = 0; ti < 4; ++ti)
#pragma unroll
        for (int tj = 0; tj < 4; ++tj) acc[ti][tj] = __builtin_amdgcn_mfma_f32_16x16x32_f16(a[ti], b[tj], acc[ti][tj], 0, 0, 0);
    }
  }
  __syncthreads();
#undef ML_ISSUE
}

FI int swz32(int row, int chunk) { return row * 64 + ((chunk ^ ((0 - (row >> 2)) & 3)) << 4); }
FI void mainloop2(f32x4 (&acc)[4][4], f32x4 (&acc2)[4][4], const h16* __restrict__ A, int lda, int mbase,
                  const h16* __restrict__ BT1, const h16* __restrict__ BT2, int ldb, int K, char* lds) {
  const int tid = threadIdx.x, lane = tid & 63, wave = tid >> 6, wr = wave >> 1, wc = wave & 1;
  uint32_t aoff[2], boff[2];
#pragma unroll
  for (int i = 0; i < 2; ++i) {
    const int row = wave * 32 + i * 16 + (lane >> 2);
    const int chunk = (lane & 3) ^ ((0 - (row >> 2)) & 3);
    int m = mbase + row; m = m < 0 ? 0 : (m > MTOK - 1 ? MTOK - 1 : m);
    aoff[i] = (uint32_t)m * lda + chunk * 8;
    boff[i] = (uint32_t)row * ldb + chunk * 8;
  }
  const int ldsw = wave * 2048 + lane * 16;
#define ML2_ISSUE(KT, BUF) do { _Pragma("unroll") for (int i = 0; i < 2; ++i) { \
    __builtin_amdgcn_global_load_lds((const unsigned*)(A + aoff[i] + (KT) * 32), (unsigned*)(lds + (BUF) * 24576 + ldsw + i * 1024), 16, 0, 0); \
    __builtin_amdgcn_global_load_lds((const unsigned*)(BT1 + boff[i] + (KT) * 32), (unsigned*)(lds + (BUF) * 24576 + 8192 + ldsw + i * 1024), 16, 0, 0); \
    __builtin_amdgcn_global_load_lds((const unsigned*)(BT2 + boff[i] + (KT) * 32), (unsigned*)(lds + (BUF) * 24576 + 16384 + ldsw + i * 1024), 16, 0, 0); } } while (0)
  const int nk = K >> 5;
  const int rA0 = wr * 64 + (lane & 15), rB0 = wc * 64 + (lane & 15), hh = lane >> 4;
  ML2_ISSUE(0, 0);
  for (int kt = 0; kt < nk; ++kt) {
    const int buf = kt & 1;
    asm volatile("s_waitcnt vmcnt(0)" ::: "memory");
    __syncthreads();
    if (kt + 1 < nk) ML2_ISSUE(kt + 1, buf ^ 1);
    const char* la = lds + buf * 24576;
    const char* lb = la + 8192;
    const char* lc = la + 16384;
    {
      h16x8 a[4], b[4], c[4];
#pragma unroll
      for (int t = 0; t < 4; ++t) {
        a[t] = *(const h16x8*)(la + swz32(rA0 + t * 16, hh));
        b[t] = *(const h16x8*)(lb + swz32(rB0 + t * 16, hh));
        c[t] = *(const h16x8*)(lc + swz32(rB0 + t * 16, hh));
      }
#pragma unroll
      for (int ti = 0; ti < 4; ++ti)
#pragma unroll
        for (int tj = 0; tj < 4; ++tj) {
          acc[ti][tj] = __builtin_amdgcn_mfma_f32_16x16x32_f16(a[ti], b[tj], acc[ti][tj], 0, 0, 0);
          acc2[ti][tj] = __builtin_amdgcn_mfma_f32_16x16x32_f16(a[ti], c[tj], acc2[ti][tj], 0, 0, 0);
        }
    }
  }
  __syncthreads();
#undef ML2_ISSUE
}

#define CROW(ti, reg) (wr * 64 + (ti) * 16 + 4 * (lane >> 4) + (reg))
#define CCOL(tj) (wc * 64 + (tj) * 16 + (lane & 15))

FI void stage_acc(const f32x4 (&acc)[4][4], float* T) {
  const int tid = threadIdx.x, lane = tid & 63, wave = tid >> 6, wr = wave >> 1, wc = wave & 1;
#pragma unroll
  for (int ti = 0; ti < 4; ++ti)
#pragma unroll
    for (int tj = 0; tj < 4; ++tj)
#pragma unroll
      for (int r = 0; r < 4; ++r) T[CROW(ti, r) * 128 + CCOL(tj)] = acc[ti][tj][r];
}

FI int win_map(int dr) {
  if (dr < 3360) return dr;
  if (dr < 3456) return -1;
  if (dr < 4480) return 3360 + (dr - 3456);
  if (dr < 5504) return 5408 + (dr - 4480);
  if (dr < 6528) return 4384 + (dr - 5504);
  return 6432 + (dr - 6528);
}
FI void transpose_tile(const float* __restrict__ src, int ldsrc, int Ksrc, int Nsrc, int mode, int rt, int ktile,
                       h16* __restrict__ dst, int lddst, float* sm) {
  const int tid = threadIdx.x;
  {
    const int rr = tid & 63, kq = tid >> 6;
    const int dr = rt * 64 + rr;
    int col = mode ? win_map(dr) : (dr < Nsrc ? dr : -1);
#pragma unroll
    for (int i = 0; i < 16; ++i) {
      int kk = kq + 4 * i, k = ktile * 64 + kk;
      float v = (col >= 0 && k < Ksrc) ? src[(size_t)k * ldsrc + col] : 0.f;
      sm[kk * 65 + rr] = v;
    }
  }
  __syncthreads();
  {
    const int dr = tid >> 2, seg = tid & 3;
    h16x8 o0, o1;
#pragma unroll
    for (int j = 0; j < 8; ++j) { o0[j] = (h16)sm[(seg * 16 + j) * 65 + dr]; o1[j] = (h16)sm[(seg * 16 + 8 + j) * 65 + dr]; }
    h16* d = dst + (size_t)(rt * 64 + dr) * lddst + ktile * 64 + seg * 16;
    *(h16x8*)d = o0; *(h16x8*)(d + 8) = o1;
  }
  __syncthreads();
}

FI void rms_rows(const Params& p, int mode, const float* __restrict__ src, const float* __restrict__ g, h16* dsth, int gw, int nw) {
  const int lane = threadIdx.x & 63;
  for (int m = gw; m < MTOK; m += nw) {
    f32x4 v[4]; float ss = 0.f;
    if (mode == 0) {
      const float* row = xrow(p, m);
#pragma unroll
      for (int i = 0; i < 4; ++i) v[i] = *(const f32x4*)(row + lane * 4 + 256 * i);
    } else {
      const h16* row = (const h16*)src + (size_t)m * DM;
#pragma unroll
      for (int i = 0; i < 4; ++i) { const h16x4 h = *(const h16x4*)(row + lane * 4 + 256 * i); v[i] = f32x4{(float)h[0], (float)h[1], (float)h[2], (float)h[3]}; }
    }
#pragma unroll
    for (int i = 0; i < 4; ++i) ss += v[i].x * v[i].x + v[i].y * v[i].y + v[i].z * v[i].z + v[i].w * v[i].w;
    ss = wave_sum(ss);
    const float rs = rsqrtf(ss * (1.f / DM) + 1e-6f);
    if (mode == 2) {
      float* o;
      if (m < NPTOK) { int s = m / TPR, t = m - s * TPR; if (t < 16) continue; o = p.out + O_YP + ((size_t)s * 2048 + (t - 16)) * DM; }
      else o = p.out + O_YS + (size_t)(m - NPTOK) * DM;
#pragma unroll
      for (int i = 0; i < 4; ++i) { f32x4 gg = *(const f32x4*)(g + lane * 4 + 256 * i); f32x4 r = v[i] * rs * gg; *(f32x4*)(o + lane * 4 + 256 * i) = r; }
    } else {
#pragma unroll
      for (int i = 0; i < 4; ++i) {
        f32x4 gg = *(const f32x4*)(g + lane * 4 + 256 * i); f32x4 r = v[i] * rs * gg;
        h16x4 h; h[0] = (h16)r.x; h[1] = (h16)r.y; h[2] = (h16)r.z; h[3] = (h16)r.w;
        *(h16x4*)(dsth + (size_t)m * DM + lane * 4 + 256 * i) = h;
      }
    }
  }
}

FI void transpose_item(const Params& p, float* sm, int it) {
  {
    int i = it;
    if (i < 2144) { transpose_tile(p.in[I_WIN], PTOT, 1024, PTOT, 1, i >> 4, i & 15, (h16*)(p.ws + WS_WIN), 1024, sm); return; }
    i -= 2144;
    if (i < 256) { transpose_tile(p.in[I_WBR], 1024, 1024, 1024, 0, i >> 4, i & 15, (h16*)(p.ws + WS_WA), 1024, sm); return; }
    i -= 256;
    if (i < 256) { transpose_tile(p.in[I_WBS], 1024, 1024, 1024, 0, i >> 4, i & 15, (h16*)(p.ws + WS_WB), 1024, sm); return; }
    i -= 256;
    if (i < 256) { transpose_tile(p.in[I_WOUT], 1024, 1024, 1024, 0, i >> 4, i & 15, (h16*)(p.ws + WS_WO), 1024, sm); return; }
    i -= 256;
    if (i < 1408) { transpose_tile(p.in[I_WUP], 5632, 1024, 5632, 0, i >> 4, i & 15, (h16*)(p.ws + WS_WUP), 1024, sm); return; }
    i -= 1408;
    if (i < 704) { transpose_tile(p.in[I_WDN], 1024, 2816, 1024, 0, i / 44, i % 44, (h16*)(p.ws + WS_WDN), 2816, sm); return; }
    i -= 704;
    if (i < 16) { transpose_tile(p.in[I_WDEC], 1024, 64, 1024, 0, i, 0, (h16*)(p.ws + WS_WLD), 64, sm); return; }
    i -= 16;
    if (i < 16) { transpose_tile(p.in[I_WAAA], 1024, 64, 1024, 0, i, 0, (h16*)(p.ws + WS_WLA), 64, sm); return; }
    i -= 16;
    transpose_tile(p.in[I_WGATE], 1024, 160, 1024, 0, i / 3, i % 3, (h16*)(p.ws + WS_WLG), 192, sm);
  }
}

FI void phase0(const Params& p, char* lds) {
  float* sm = (float*)lds;
  h16* ws = (h16*)p.ws;
  for (int it = blockIdx.x; it < 2144 + 80; it += gridDim.x) transpose_item(p, sm, it < 2144 ? it : it + 2880);
  (void)ws;
  rms_rows(p, 0, nullptr, p.in[I_N1G], (h16*)(p.ws + WS_A), blockIdx.x * 4 + (threadIdx.x >> 6), gridDim.x * 4);
}

struct F8 { f32x4 a, b; };
FI F8 ld16(const h16* q) { h16x8 v = *(const h16x8*)q; F8 r; r.a = f32x4{(float)v[0], (float)v[1], (float)v[2], (float)v[3]}; r.b = f32x4{(float)v[4], (float)v[5], (float)v[6], (float)v[7]}; return r; }
FI F8 ld32(const float* q) { F8 r; r.a = *(const f32x4*)q; r.b = *(const f32x4*)(q + 4); return r; }
FI F8 zero8() { F8 r; r.a = f32x4{0.f, 0.f, 0.f, 0.f}; r.b = r.a; return r; }
FI void st16(h16* q, const F8& v) { h16x8 h; h[0] = (h16)v.a.x; h[1] = (h16)v.a.y; h[2] = (h16)v.a.z; h[3] = (h16)v.a.w; h[4] = (h16)v.b.x; h[5] = (h16)v.b.y; h[6] = (h16)v.b.z; h[7] = (h16)v.b.w; *(h16x8*)q = h; }
FI void st32(float* q, const F8& v) { *(f32x4*)q = v.a; *(f32x4*)(q + 4) = v.b; }
FI void stage16(const f32x4 (&acc)[4][4], h16* T) {
  const int tid = threadIdx.x, lane = tid & 63, wave = tid >> 6, wr = wave >> 1, wc = wave & 1;
#pragma unroll
  for (int ti = 0; ti < 4; ++ti)
#pragma unroll
    for (int tj = 0; tj < 4; ++tj)
#pragma unroll
      for (int r = 0; r < 4; ++r) T[CROW(ti, r) * 128 + CCOL(tj)] = (h16)acc[ti][tj][r];
}
typedef _Float16 h16x2 __attribute__((ext_vector_type(2)));
FI void pack_acc(const f32x4 (&acc)[4][4], uint32_t (&pk)[4][4][2]) {
#pragma unroll
  for (int ti = 0; ti < 4; ++ti)
#pragma unroll
    for (int tj = 0; tj < 4; ++tj)
#pragma unroll
      for (int r = 0; r < 4; r += 2) {
        h16x2 h2; h2[0] = (h16)acc[ti][tj][r]; h2[1] = (h16)acc[ti][tj][r + 1];
        pk[ti][tj][r >> 1] = __builtin_bit_cast(uint32_t, h2);
      }
}
FI void stage16_pk(const uint32_t (&pk)[4][4][2], h16* T) {
  const int tid = threadIdx.x, lane = tid & 63, wave = tid >> 6, wr = wave >> 1, wc = wave & 1;
#pragma unroll
  for (int ti = 0; ti < 4; ++ti)
#pragma unroll
    for (int tj = 0; tj < 4; ++tj)
#pragma unroll
      for (int r = 0; r < 4; r += 2) {
        h16x2 h2 = __builtin_bit_cast(h16x2, pk[ti][tj][r >> 1]);
        T[CROW(ti, r) * 128 + CCOL(tj)] = h2[0];
        T[CROW(ti, r + 1) * 128 + CCOL(tj)] = h2[1];
      }
}
FI void conv_prev(const h16* T, int row, int c8, const Tok& k, const float* st  , int ld, F8& p1, F8& p2) {
  if (k.t >= 2) { p1 = ld16(T + (row - 1) * 128 + c8); p2 = ld16(T + (row - 2) * 128 + c8); }
  else if (k.t == 1) { p1 = ld16(T + (row - 1) * 128 + c8); p2 = k.seq >= 8 ? ld32(st + ld) : zero8(); }
  else { if (k.seq >= 8) { p1 = ld32(st + ld); p2 = ld32(st); } else { p1 = zero8(); p2 = zero8(); } }
}

FI h16x8 cvth(const F8& v) { h16x8 h; h[0] = (h16)v.a.x; h[1] = (h16)v.a.y; h[2] = (h16)v.a.z; h[3] = (h16)v.a.w; h[4] = (h16)v.b.x; h[5] = (h16)v.b.y; h[6] = (h16)v.b.z; h[7] = (h16)v.b.w; return h; }
FI F8 cvtf(const h16x8& v) { F8 r; r.a = f32x4{(float)v[0], (float)v[1], (float)v[2], (float)v[3]}; r.b = f32x4{(float)v[4], (float)v[5], (float)v[6], (float)v[7]}; return r; }
FI h16x8 zeroh() { h16x8 h; for (int i = 0; i < 8; ++i) h[i] = (h16)0.f; return h; }
FI void conv_prev16(const h16* T, int row, int c8, const Tok& k, const float* st  , int ld, h16x8& p1, h16x8& p2) {
  if (k.t >= 2) { p1 = *(const h16x8*)(T + (row - 1) * 128 + c8); p2 = *(const h16x8*)(T + (row - 2) * 128 + c8); }
  else if (k.t == 1) { p1 = *(const h16x8*)(T + (row - 1) * 128 + c8); p2 = k.seq >= 8 ? cvth(ld32(st + ld)) : zeroh(); }
  else { if (k.seq >= 8) { p1 = cvth(ld32(st + ld)); p2 = cvth(ld32(st)); } else { p1 = zeroh(); p2 = zeroh(); } }
}

FI void phase1(const Params& p, char* lds) {
  const int tid = threadIdx.x;
  const h16* XN = (const h16*)(p.ws + WS_A);
  const h16* WinT = (const h16*)(p.ws + WS_WIN);
  h16* PB = (h16*)(p.ws + WS_B);
  h16* ZB = (h16*)(p.ws + WS_C);
  h16* LA = (h16*)(p.ws + WS_E);
  const int c8 = (tid & 15) * 8, r0 = tid >> 4;
  for (int it = blockIdx.x; it < 35 * NMT_H; it += gridDim.x) {
    const int j = it / NMT_H, mt = it - j * NMT_H;
    const int mbase = mt * 126 - 2;
    {
      const int npass = j < 8 ? 3 : 1;
      uint32_t pk[4][4][2];
#pragma unroll 1
      for (int pass = 0; pass < npass; ++pass) {
        int brow;
        if (j < 8) brow = (pass == 0 ? 3456 : (pass == 1 ? 4480 : 5504)) + j * 128;
        else brow = (j - 8) * 128;
        f32x4 acc[4][4];
        zero_acc(acc);
        mainloop(acc, XN, DM, mbase, WinT + (size_t)brow * DM, DM, DM, lds);
        if (j < 8) {
          if (pass == 0) pack_acc(acc, pk);
          else if (pass == 1) {
#pragma unroll
            for (int ti = 0; ti < 4; ++ti)
#pragma unroll
              for (int tj = 0; tj < 4; ++tj)
#pragma unroll
                for (int r = 0; r < 4; r += 2) {
                  h16x2 h2 = __builtin_bit_cast(h16x2, pk[ti][tj][r >> 1]);
                  h2[0] = (h16)((float)h2[0] * acc[ti][tj][r]); h2[1] = (h16)((float)h2[1] * acc[ti][tj][r + 1]);
                  pk[ti][tj][r >> 1] = __builtin_bit_cast(uint32_t, h2);
                }
          } else { stage16_pk(pk, (h16*)lds); stage16(acc, (h16*)lds + 16384); }
        } else stage_acc(acc, (float*)lds);
      }
    }
    if (j < 8) {
      const int n0 = j * 128;
      h16* TU = (h16*)lds; h16* TB = TU + 16384;
      __syncthreads();
      const int ch = n0 + c8;
      const float* cw = p.in[I_CSC];
      const h16x8 w0 = cvth(ld32(cw + ch)), w1 = cvth(ld32(cw + 1024 + ch)), w2 = cvth(ld32(cw + 2048 + ch));
#pragma unroll 1
      for (int i = 0; i < 8; ++i) {
        const int row = r0 + 16 * i, m = mbase + row;
        if (row < 2 || m >= MTOK) continue;
        const Tok k = tokinfo(m);
        const h16x8 cur = *(const h16x8*)(TU + row * 128 + c8), bg = *(const h16x8*)(TB + row * 128 + c8);
        h16x8 p1, p2;
        conv_prev16(TU, row, c8, k, p.in[I_SSC] + (size_t)(k.seq - 8) * 2048 + ch, 1024, p1, p2);
        *(h16x8*)(ZB + (size_t)m * DM + ch) = bg * (w0 * p2 + w1 * p1 + w2 * cur);
        if (k.t >= k.T - 2) st32(p.out + O_SC + (size_t)k.seq * 2048 + (k.t - (k.T - 2)) * 1024 + ch, cvtf(cur));
      }
      __syncthreads();
    } else {
      const int n0 = (j - 8) * 128;
      float* T = (float*)lds;
      __syncthreads();
      const int n = n0 + c8;
      const F8 muv = n < RWP ? ld32(p.in[I_MU] + n) : zero8();
#pragma unroll 1
      for (int i = 0; i < 8; ++i) {
        const int row = r0 + 16 * i, m = mbase + row;
        if (row < 2 || m >= MTOK) continue;
        const Tok k = tokinfo(m);
        const F8 cur = ld32(T + row * 128 + c8);
        F8 prev;
        if (k.t >= 1) prev = ld32(T + (row - 1) * 128 + c8);
        else prev = (k.seq >= 8 && n < RWP) ? ld32(p.in[I_SSH] + (size_t)(k.seq - 8) * RWP + n) : zero8();
        F8 xs;
        xs.a = cur.a + (prev.a - cur.a) * muv.a;
        xs.b = cur.b + (prev.b - cur.b) * muv.b;
        if (n < 3072) st16(PB + (size_t)m * 3072 + n, xs);
        else {
          const int q = n - 3072;
          if (q < LAW) {
            F8 v;
            if (q < 64) { v.a = f32x4{tanh_(xs.a.x), tanh_(xs.a.y), tanh_(xs.a.z), tanh_(xs.a.w)}; v.b = f32x4{tanh_(xs.b.x), tanh_(xs.b.y), tanh_(xs.b.z), tanh_(xs.b.w)}; }
            else if (q < 128) v = xs;
            else if (q < 288) { v.a = f32x4{sigm(xs.a.x), sigm(xs.a.y), sigm(xs.a.z), sigm(xs.a.w)}; v.b = f32x4{sigm(xs.b.x), sigm(xs.b.y), sigm(xs.b.z), sigm(xs.b.w)}; }
            else v = zero8();
            st16(LA + (size_t)m * LAW + q, v);
          }
        }
        if (n < RWP && k.t == k.T - 1) st32(p.out + O_SH + (size_t)k.seq * RWP + n, cur);
      }
      __syncthreads();
    }
  }
}

template <int CTRL> FI float dpp_mov(float v) { return __builtin_bit_cast(float, __builtin_amdgcn_update_dpp(0, __builtin_bit_cast(int, v), CTRL, 0xF, 0xF, true)); }
FI float row8_sum(float v) { v += dpp_mov<0xB1>(v); v += dpp_mov<0x4E>(v); v += dpp_mov<0x141>(v); return v; }
FI float row16_sum(float v) { v = row8_sum(v); v += dpp_mov<0x140>(v); return v; }

constexpr size_t OUT_Y_BYTES = 34865152;
constexpr size_t WS_YS = WS_END + 65536;
constexpr size_t WS_RK = WS_YS + 1048576;
FI h16* yrow(const Params& p, int m) {
  return m < NPTOK ? (h16*)((char*)p.out + OUT_Y_BYTES) + (size_t)m * DM : (h16*)(p.ws + WS_YS) + (size_t)(m - NPTOK) * DM;
}

FI void phaseA(const Params& p, char* lds) {
  const int tid = threadIdx.x, lane = tid & 63, wave = tid >> 6, wr = wave >> 1, wc = wave & 1;
  const h16* LA = (const h16*)(p.ws + WS_E);
  h16* DA = (h16*)p.out;
  h16* AA = (h16*)(p.ws + WS_D);
  for (int it = blockIdx.x; it < 16 * NMT; it += gridDim.x) {
    const int j = it / NMT, mt = it - j * NMT;
    const int mbase = mt * 128, which = j >> 3, n0 = (j & 7) * 128;
    f32x4 acc[4][4];
    zero_acc(acc);
    if (which == 0) mainloop(acc, LA, LAW, mbase, (const h16*)(p.ws + WS_WLD) + (size_t)n0 * 64, 64, 64, lds);
    else mainloop(acc, LA + 64, LAW, mbase, (const h16*)(p.ws + WS_WLA) + (size_t)n0 * 64, 64, 64, lds);
    h16* dst = which == 0 ? DA : AA;
    stage_acc(acc, (float*)lds);
    __syncthreads();
    if (which == 0) {
      const float* T = (const float*)lds;
      const int ci = tid >> 5, cq = (tid & 31) * 4, n = n0 + cq;
      const f32x4 bias = *(const f32x4*)(p.in[I_W0] + n);
      f32x4 run = {1.f, 1.f, 1.f, 1.f};
#pragma unroll 1
      for (int rr = 0; rr < 16; ++rr) {
        const int row = ci * 16 + rr, m = mbase + row;
        if (m >= NPTOK && (m & 3) == 0) run = f32x4{1.f, 1.f, 1.f, 1.f};
        const f32x4 x = *(const f32x4*)(T + row * 128 + cq) + bias;
        run = run * f32x4{__expf(-0.60653066f * sigm(x.x)), __expf(-0.60653066f * sigm(x.y)), __expf(-0.60653066f * sigm(x.z)), __expf(-0.60653066f * sigm(x.w))};
        h16x4 h; h[0] = (h16)run.x; h[1] = (h16)run.y; h[2] = (h16)run.z; h[3] = (h16)run.w;
        *(h16x4*)(dst + (size_t)m * DM + n) = h;
      }
    } else {
      const float* T = (const float*)lds;
      const int c8 = (tid & 15) * 8, r0 = tid >> 4, n = n0 + c8;
      const float* w0p = p.in[I_W0]; const float* a0p = p.in[I_A0];
      const F8 bias = ld32((which == 0 ? w0p : a0p) + n);
#pragma unroll 1
      for (int i = 0; i < 8; ++i) {
        const int row = r0 + 16 * i, m = mbase + row;
        const F8 a = ld32(T + row * 128 + c8);
        const f32x4 xa = a.a + bias.a, xb = a.b + bias.b;
        F8 o;
        o.a = f32x4{sigm(xa.x), sigm(xa.y), sigm(xa.z), sigm(xa.w)}; o.b = f32x4{sigm(xb.x), sigm(xb.y), sigm(xb.z), sigm(xb.w)};
        if (which == 0) {
          o.a = f32x4{__expf(-0.60653066f * o.a.x), __expf(-0.60653066f * o.a.y), __expf(-0.60653066f * o.a.z), __expf(-0.60653066f * o.a.w)};
          o.b = f32x4{__expf(-0.60653066f * o.b.x), __expf(-0.60653066f * o.b.y), __expf(-0.60653066f * o.b.z), __expf(-0.60653066f * o.b.w)};
        }
        st16(dst + (size_t)m * DM + n, o);
      }
    }
    __syncthreads();
  }
}

FI void scan_unit(const Params& p, float* sm, int seq, int head, int half) {
  const int tid = threadIdx.x;
  const int T = seq < 8 ? TPR : 4;
  const int mseq = seq < 8 ? seq * TPR : NPTOK + (seq - 8) * 4;
  const h16* PB = (const h16*)(p.ws + WS_B);
  const h16* DA = (const h16*)p.out;
  const h16* AA = (const h16*)(p.ws + WS_D);
  const int rp = tid >> 4, cb = tid & 15;
  const int chp = head * 64 + cb * 4;
  const int row0 = half * 32 + rp * 2;
  f32x2 S0a, S0b, S1a, S1b;
  if (seq >= 8) {
    const float* sp = p.in[I_SWKV] + ((size_t)(seq - 8) * 16 + head) * 4096 + row0 * 64 + cb * 4;
    const f32x4 u = *(const f32x4*)sp, w = *(const f32x4*)(sp + 64);
    S0a = f32x2{u.x, u.y}; S0b = f32x2{u.z, u.w}; S1a = f32x2{w.x, w.y}; S1b = f32x2{w.z, w.w};
  } else { S0a = f32x2{0.f, 0.f}; S0b = S0a; S1a = S0a; S1b = S0a; }
  const f32x4 kkc = *(const f32x4*)(p.in[I_KK] + chp), kac = *(const f32x4*)(p.in[I_KA] + chp), rkc = *(const f32x4*)(p.in[I_RK] + chp);
  float* RKo = (float*)(p.ws + WS_RK);
  const int nch = (T + 15) >> 4;
  h16x2* YPbase = (h16x2*)(sm + 11264);
  h16x4 Apr, Apk, Apv, Apd, Apa, Ape, Bpr, Bpk, Bpv, Bpd, Bpa, Bpe, Cpr, Cpk, Cpv, Cpd, Cpa, Cpe;
#define SC_LOAD(P, T0) do { int mp = (T0) + rp; if (mp > T - 1) mp = T - 1; const size_t mm = (size_t)(mseq + mp); \
    const h16* pp = PB + mm * 3072 + chp; P##pr = *(const h16x4*)pp; P##pk = *(const h16x4*)(pp + 1024); P##pv = *(const h16x4*)(pp + 2048); \
    P##pd = *(const h16x4*)(DA + mm * DM + chp); P##pa = *(const h16x4*)(AA + mm * DM + chp); \
    P##pe = *(const h16x4*)(DA + (mm - (rp > 0 ? 1 : 0)) * DM + chp); } while (0)
#define SC_PREP(P, BUF, T0) do { float* bb = sm + (BUF) * 5632; \
    const f32x4 r4 = {(float)P##pr[0], (float)P##pr[1], (float)P##pr[2], (float)P##pr[3]}; \
    const f32x4 k4 = {(float)P##pk[0], (float)P##pk[1], (float)P##pk[2], (float)P##pk[3]}; \
    const f32x4 v4 = {(float)P##pv[0], (float)P##pv[1], (float)P##pv[2], (float)P##pv[3]}; \
    const f32x4 lam = {(float)P##pd[0], (float)P##pd[1], (float)P##pd[2], (float)P##pd[3]}; \
    f32x4 lam1 = {(float)P##pe[0], (float)P##pe[1], (float)P##pe[2], (float)P##pe[3]}; \
    if (rp == 0) lam1 = f32x4{1.f, 1.f, 1.f, 1.f}; \
    const f32x4 linv = f32x4{__builtin_amdgcn_rcpf(lam.x), __builtin_amdgcn_rcpf(lam.y), __builtin_amdgcn_rcpf(lam.z), __builtin_amdgcn_rcpf(lam.w)}; \
    const f32x4 a4 = {(float)P##pa[0], (float)P##pa[1], (float)P##pa[2], (float)P##pa[3]}; \
    const f32x4 kkv = k4 * kkc; \
    const float ss = row16_sum(kkv.x * kkv.x + kkv.y * kkv.y + kkv.z * kkv.z + kkv.w * kkv.w); \
    const f32x4 kk = kkv * __builtin_amdgcn_rcpf(fmaxf(__builtin_amdgcn_sqrtf(ss), 1e-12f)); \
    const int o = rp * 64 + cb * 4; \
      \
    const f32x4 kp_ = k4 * (1.f + (a4 - 1.f) * kac); \
    { const f32x4 rk4_ = r4 * kp_ * rkc; const float rks_ = row16_sum((rk4_.x + rk4_.y) + (rk4_.z + rk4_.w)); \
      if (half == 0 && cb == 0 && (T0) + rp < T) RKo[(size_t)(mseq + (T0) + rp) * 16 + head] = rks_; } \
    *(f32x4*)(bb + o) = r4 * lam; *(f32x4*)(bb + 1024 + o) = lam; *(f32x4*)(bb + 2048 + o) = kp_ * linv; \
    if ((cb >> 3) == half) *(f32x4*)(bb + 5120 + rp * 32 + (cb & 7) * 4) = v4;     \
    *(f32x4*)(bb + 3072 + o) = -kk * lam1; *(f32x4*)(bb + 4096 + o) = kk * a4 * linv; } while (0)
#define ST_LOAD(X, TT) do { const float* q_ = bb + (TT) * 64 + cb * 4; \
    X##a = *(const f32x4*)(q_ + 3072); X##b = *(const f32x4*)(q_ + 4096); \
    X##k = *(const f32x4*)(q_ + 2048); X##r = *(const f32x4*)q_; X##v = *(const f32x2*)(bb + 5120 + (TT) * 32 + rp * 2); } while (0)
#define LO(v) f32x2{(v).x, (v).y}
#define HI(v) f32x2{(v).z, (v).w}
#define ST_COMP(X, TT) do { \
    f32x2 s0_ = S0a * LO(X##a), s1_ = S1a * LO(X##a); s0_ = S0b * HI(X##a) + s0_; s1_ = S1b * HI(X##a) + s1_; \
    const f32x2 v0_ = {X##v.x, X##v.x}, v1_ = {X##v.y, X##v.y}; \
    const f32x2 u0a_ = LO(X##k) * v0_ + S0a, u0b_ = HI(X##k) * v0_ + S0b; \
    const f32x2 u1a_ = LO(X##k) * v1_ + S1a, u1b_ = HI(X##k) * v1_ + S1b; \
    const float sa0_ = row16_sum(s0_.x + s0_.y), sa1_ = row16_sum(s1_.x + s1_.y); \
    const f32x2 q0_ = {sa0_, sa0_}, q1_ = {sa1_, sa1_}; \
    S0a = LO(X##b) * q0_ + u0a_; S0b = HI(X##b) * q0_ + u0b_; S1a = LO(X##b) * q1_ + u1a_; S1b = HI(X##b) * q1_ + u1b_; \
    f32x2 y0_ = S0a * LO(X##r), y1_ = S1a * LO(X##r); y0_ = S0b * HI(X##r) + y0_; y1_ = S1b * HI(X##r) + y1_; \
    { h16x2 yp_; yp_[0] = (h16)(y0_.x + y0_.y); yp_[1] = (h16)(y1_.x + y1_.y); YP[(TT) * 256 + tid] = yp_; } } while (0)
#define SC_BODY(c, LSET, PSET) do { \
    const int t0 = (c) * 16; \
    const int nt = (T - t0) < 16 ? (T - t0) : 16;       \
    const float* bb = sm + ((c) & 1) * 5632; \
    h16x2* YP = YPbase + ((c) & 1) * 4096; \
    if ((c) + 3 < nch) SC_LOAD(LSET, t0 + 48); \
    if ((c) > 0) SC_YRED((c) - 1, 16); \
    { \
      f32x4 Aa, Ab, Ak, Ar; f32x2 Av; \
      f32x4 Ba, Bb, Bk, Br; f32x2 Bv; \
      ST_LOAD(A, 0); \
      for (int tt = 0; tt < nt; tt += 2) { \
        ST_LOAD(B, tt + 1); \
        ST_COMP(A, tt); \
        const int tn = tt + 2 < nt ? tt + 2 : tt; \
        ST_LOAD(A, tn); \
        ST_COMP(B, tt + 1); \
      } \
    } \
    {   \
      const f32x4 ll_ = *(const f32x4*)(bb + 1024 + (nt - 1) * 64 + cb * 4); \
      S0a = S0a * LO(ll_); S0b = S0b * HI(ll_); S1a = S1a * LO(ll_); S1b = S1b * HI(ll_); } \
    if ((c) + 1 < nch) SC_PREP(PSET, ((c) + 1) & 1, t0 + 16);     \
    __syncthreads(); } while (0)
#define SC_YRED(CC, NT) do { if (rp < (NT)) { \
      const uint4* q_ = (const uint4*)(YPbase + ((CC) & 1) * 4096 + rp * 256 + cb * 16); \
      float a0_ = 0.f, a1_ = 0.f; \
      _Pragma("unroll") for (int e_ = 0; e_ < 4; ++e_) { \
        const uint4 w_ = q_[e_]; \
        const h16x2 p0_ = __builtin_bit_cast(h16x2, w_.x), p1_ = __builtin_bit_cast(h16x2, w_.y), p2_ = __builtin_bit_cast(h16x2, w_.z), p3_ = __builtin_bit_cast(h16x2, w_.w); \
        a0_ += ((float)p0_[0] + (float)p1_[0]) + ((float)p2_[0] + (float)p3_[0]); \
        a1_ += ((float)p0_[1] + (float)p1_[1]) + ((float)p2_[1] + (float)p3_[1]); \
      } \
      h16x2 yh; yh[0] = (h16)a0_; yh[1] = (h16)a1_; \
      *(h16x2*)(yrow(p, mseq + (CC) * 16 + rp) + head * 64 + half * 32 + cb * 2) = yh; } } while (0)
  SC_LOAD(A, 0);
  if (nch > 1) { SC_LOAD(B, 16); SC_LOAD(C, 32); }
  SC_PREP(A, 0, 0);
  __syncthreads();
  for (int c = 0; c < nch; c += 3) {
    SC_BODY(c, A, B);
    if (c + 1 < nch) SC_BODY(c + 1, B, C);
    if (c + 2 < nch) SC_BODY(c + 2, C, A);
  }
#undef SC_BODY
  SC_YRED(nch - 1, T - (nch - 1) * 16);
#undef SC_YRED
  {
    float* op = p.out + O_WKV + ((size_t)seq * 16 + head) * 4096 + row0 * 64 + cb * 4;
    *(f32x4*)op = f32x4{S0a.x, S0a.y, S0b.x, S0b.y}; *(f32x4*)(op + 64) = f32x4{S1a.x, S1a.y, S1b.x, S1b.y};
  }
  __syncthreads();
#undef SC_LOAD
#undef SC_PREP
#undef ST_LOAD
#undef ST_COMP
#undef LO
#undef HI
}

FI void phase3(const Params& p, char* lds) {
  float* sm = (float*)lds;
  const int G = gridDim.x, b = blockIdx.x;
  for (int u = b; u < 256; u += G) scan_unit(p, sm, u >> 5, (u >> 1) & 15, u & 1);
  if (G > 256) {
    if (b >= 256) {
      for (int u = b - 256; u < 4096; u += G - 256) scan_unit(p, sm, 8 + (u >> 5), (u >> 1) & 15, u & 1);
      for (int it = 2144 + (b - 256); it < 5024; it += G - 256) transpose_item(p, sm, it);
    }
  }
  else {
    for (int u = b; u < 4096; u += G) scan_unit(p, sm, 8 + (u >> 5), (u >> 1) & 15, u & 1);
    for (int it = 2144 + b; it < 5024; it += G) transpose_item(p, sm, it);
  }
}

FI void phase3b(const Params& p, char* lds) {
  const int tid = threadIdx.x;
  const h16* LA = (const h16*)(p.ws + WS_E);
  const h16* PB = (const h16*)(p.ws + WS_B);
  h16* AZ = (h16*)(p.ws + WS_D);
  const float* RK = (const float*)(p.ws + WS_RK);
  h16* TG = (h16*)lds;
  const int c8 = (tid & 15) * 8, r0 = tid >> 4;
  for (int it = blockIdx.x; it < 8 * NMT; it += gridDim.x) {
    const int j = it / NMT, mt = it - j * NMT;
    const int mbase = mt * 128, n0 = j * 128;
    {
      f32x4 acc[4][4];
      zero_acc(acc);
      mainloop(acc, LA + 128, LAW, mbase, (const h16*)(p.ws + WS_WLG) + (size_t)n0 * 192, 192, 192, lds);
      stage16(acc, TG);
    }
    __syncthreads();
    const int ch = n0 + c8;
    const F8 lg = ld32(p.in[I_LNG] + ch), lb = ld32(p.in[I_LNB] + ch);
#pragma unroll 1
    for (int i = 0; i < 8; ++i) {
      const int row = r0 + 16 * i, m = mbase + row;
      const F8 y = ld16(yrow(p, m) + ch);
      const F8 v = ld16(PB + (size_t)m * 3072 + 2048 + ch);
      const F8 g = ld16(TG + row * 128 + c8);
      const float rk = RK[(size_t)m * 16 + (ch >> 6)];
      const f32x4 ys = y.a + y.b;
      const float mean = row8_sum((ys.x + ys.y) + (ys.z + ys.w)) * (1.f / 64.f);
      F8 d; d.a = y.a - mean; d.b = y.b - mean;
      const f32x4 d2 = d.a * d.a + d.b * d.b;
      const float var = row8_sum((d2.x + d2.y) + (d2.z + d2.w)) * (1.f / 64.f);
      const float rs = rsqrtf(var + 64e-5f);
      F8 z;
      z.a = (d.a * rs * lg.a + lb.a + v.a * rk) * g.a;
      z.b = (d.b * rs * lg.b + lb.b + v.b * rk) * g.b;
      st16(AZ + (size_t)m * DM + ch, z);
    }
    __syncthreads();
  }
}

FI void phase4(const Params& p, char* lds) {
  const int tid = threadIdx.x;
  const h16* XN = (const h16*)(p.ws + WS_A);
  const h16* ZA = (const h16*)(p.ws + WS_D);
  const h16* ZB = (const h16*)(p.ws + WS_C);
  const h16* WinT = (const h16*)(p.ws + WS_WIN);
  const h16* WA = (const h16*)(p.ws + WS_WA);
  const h16* WB = (const h16*)(p.ws + WS_WB);
  h16* MG = (h16*)(p.ws + WS_B);
  h16* G2 = (h16*)(p.ws + WS_B + OUT_Y_BYTES);
  h16* T0 = (h16*)lds; h16* T1 = T0 + 16384;
  const int c8 = (tid & 15) * 8, r0 = tid >> 4;
  for (int it = blockIdx.x; it < 8 * NMT; it += gridDim.x) {
    const int j = it / NMT, mt = it - j * NMT;
    const int mbase = mt * 128, n0 = j * 128, n = n0 + c8;
    {
      f32x4 acc[4][4], acc2[4][4];
      zero_acc(acc); zero_acc(acc2);
      mainloop2(acc, acc2, XN, DM, mbase, WinT + (size_t)(6528 + n0) * DM, WinT + (size_t)(7552 + n0) * DM, DM, DM, lds);
      stage16(acc, T0); stage16(acc2, T1);
    }
    __syncthreads();
    {
      const F8 ba = ld32(p.in[I_BG] + n), bb = ld32(p.in[I_BG] + 1024 + n);
#pragma unroll 1
      for (int i = 0; i < 8; ++i) {
        const int row = r0 + 16 * i; const size_t o = (size_t)(mbase + row) * DM + n;
        const F8 a = ld16(T0 + row * 128 + c8), b = ld16(T1 + row * 128 + c8);
        const f32x4 xa = a.a + ba.a, xb = a.b + ba.b, ya = b.a + bb.a, yb = b.b + bb.b;
        F8 ga, gb;
        ga.a = f32x4{sigm(xa.x), sigm(xa.y), sigm(xa.z), sigm(xa.w)}; ga.b = f32x4{sigm(xb.x), sigm(xb.y), sigm(xb.z), sigm(xb.w)};
        gb.a = f32x4{sigm(ya.x), sigm(ya.y), sigm(ya.z), sigm(ya.w)}; gb.b = f32x4{sigm(yb.x), sigm(yb.y), sigm(yb.z), sigm(yb.w)};
        st16(MG + o, ga); st16(G2 + o, gb);
      }
    }
    __syncthreads();
  }
  for (int it = blockIdx.x; it < 8 * NMT; it += gridDim.x) {
    const int j = it / NMT, mt = it - j * NMT;
    const int mbase = mt * 128, n0 = j * 128, n = n0 + c8;
    {
      uint32_t pk[4][4][2];
#pragma unroll 1
      for (int pass = 0; pass < 2; ++pass) {
        f32x4 acc[4][4];
        zero_acc(acc);
        mainloop(acc, pass == 0 ? ZA : ZB, DM, mbase, (pass == 0 ? WA : WB) + (size_t)n0 * DM, DM, DM, lds);
        if (pass == 0) pack_acc(acc, pk);
        else { stage16_pk(pk, T0); stage16(acc, T1); }
      }
    }
    __syncthreads();
#pragma unroll 1
    for (int i = 0; i < 8; ++i) {
      const int row = r0 + 16 * i; const size_t o = (size_t)(mbase + row) * DM + n;
      const h16x8 oa = *(const h16x8*)(T0 + row * 128 + c8), ob = *(const h16x8*)(T1 + row * 128 + c8);
      const h16x8 ga = *(const h16x8*)(MG + o), gb = *(const h16x8*)(G2 + o);
      *(h16x8*)(MG + o) = ga * oa + gb * ob;
    }
    __syncthreads();
  }
}

FI void phase5(const Params& p, char* lds) {
  const int tid = threadIdx.x, lane = tid & 63, wave = tid >> 6, wr = wave >> 1, wc = wave & 1;
  const h16* MG = (const h16*)(p.ws + WS_B);
  const h16* WO = (const h16*)(p.ws + WS_WO);
  h16* X1 = (h16*)(p.ws + WS_A);
  for (int it = blockIdx.x; it < 8 * NMT; it += gridDim.x) {
    const int j = it / NMT, mt = it - j * NMT;
    const int mbase = mt * 128, n0 = j * 128;
    f32x4 acc[4][4];
    zero_acc(acc);
    mainloop(acc, MG, DM, mbase, WO + (size_t)n0 * DM, DM, DM, lds);
    stage_acc(acc, (float*)lds);
    __syncthreads();
    {
      const float* T = (const float*)lds;
      const int c8 = (tid & 15) * 8, r0 = tid >> 4, n = n0 + c8;
#pragma unroll 1
      for (int i = 0; i < 8; ++i) {
        const int row = r0 + 16 * i, m = mbase + row;
        const F8 a = ld32(T + row * 128 + c8), x = ld32(xrow(p, m) + n);
        F8 o; o.a = x.a + a.a; o.b = x.b + a.b;
        st16(X1 + (size_t)m * DM + n, o);
      }
    }
    __syncthreads();
  }
}

FI void phase7(const Params& p, char* lds) {
  const int tid = threadIdx.x;
  const h16* XN2 = (const h16*)(p.ws + WS_D);
  const h16* WUP = (const h16*)(p.ws + WS_WUP);
  h16* HH = (h16*)(p.ws + WS_B);
  h16* TG = (h16*)lds; h16* TV = TG + 16384;
  const int c8 = (tid & 15) * 8, r0 = tid >> 4;
  for (int it = blockIdx.x; it < 22 * NMT_H; it += gridDim.x) {
    const int j = it / NMT_H, mt = it - j * NMT_H;
    const int mbase = mt * 126 - 2, n0 = j * 128;
    {
      f32x4 acc[4][4], acc2[4][4];
      zero_acc(acc); zero_acc(acc2);
      mainloop2(acc, acc2, XN2, DM, mbase, WUP + (size_t)n0 * DM, WUP + (size_t)(DFF + n0) * DM, DM, DM, lds);
      stage16(acc, TG); stage16(acc2, TV);
    }
    __syncthreads();
    const int cgc = n0 + c8, cvc = DFF + n0 + c8;
    const float* cw = p.in[I_CFFN];
    const h16x8 g0 = cvth(ld32(cw + cgc)), g1 = cvth(ld32(cw + 5632 + cgc)), g2 = cvth(ld32(cw + 11264 + cgc));
    const h16x8 v0 = cvth(ld32(cw + cvc)), v1 = cvth(ld32(cw + 5632 + cvc)), v2 = cvth(ld32(cw + 11264 + cvc));
#pragma unroll 1
    for (int i = 0; i < 8; ++i) {
      const int row = r0 + 16 * i, m = mbase + row;
      if (row < 2 || m >= MTOK) continue;
      const Tok k = tokinfo(m);
      const h16x8 gc = *(const h16x8*)(TG + row * 128 + c8), vc = *(const h16x8*)(TV + row * 128 + c8);
      h16x8 gp1, gp2, vp1, vp2;
      const float* st = p.in[I_SFFN] + (size_t)(k.seq - 8) * 11264;
      conv_prev16(TG, row, c8, k, st + cgc, 5632, gp1, gp2);
      conv_prev16(TV, row, c8, k, st + cvc, 5632, vp1, vp2);
      const h16x8 cgh = g0 * gp2 + g1 * gp1 + g2 * gc;
      const h16x8 cvh = v0 * vp2 + v1 * vp1 + v2 * vc;
      const F8 cg_ = cvtf(cgh);
      F8 sl;
      sl.a = f32x4{cg_.a.x * sigm(cg_.a.x), cg_.a.y * sigm(cg_.a.y), cg_.a.z * sigm(cg_.a.z), cg_.a.w * sigm(cg_.a.w)};
      sl.b = f32x4{cg_.b.x * sigm(cg_.b.x), cg_.b.y * sigm(cg_.b.y), cg_.b.z * sigm(cg_.b.z), cg_.b.w * sigm(cg_.b.w)};
      *(h16x8*)(HH + (size_t)m * DFF + n0 + c8) = cvth(sl) * cvh;
      if (k.t >= k.T - 2) {
        float* fo = p.out + O_FFN + (size_t)k.seq * 11264 + (k.t - (k.T - 2)) * 5632;
        st32(fo + cgc, cvtf(gc)); st32(fo + cvc, cvtf(vc));
      }
    }
    __syncthreads();
  }
}

FI void phase8(const Params& p, char* lds) {
  const int tid = threadIdx.x, lane = tid & 63, wave = tid >> 6, wr = wave >> 1, wc = wave & 1;
  const h16* HH = (const h16*)(p.ws + WS_B);
  const h16* WDN = (const h16*)(p.ws + WS_WDN);
  h16* X1 = (h16*)(p.ws + WS_A);
  for (int it = blockIdx.x; it < 8 * NMT; it += gridDim.x) {
    const int j = it / NMT, mt = it - j * NMT;
    const int mbase = mt * 128, n0 = j * 128;
    f32x4 acc[4][4];
    zero_acc(acc);
    mainloop(acc, HH, DFF, mbase, WDN + (size_t)n0 * DFF, DFF, DFF, lds);
    stage_acc(acc, (float*)lds);
    __syncthreads();
    {
      const float* T = (const float*)lds;
      const int c8 = (tid & 15) * 8, r0 = tid >> 4, n = n0 + c8;
#pragma unroll 1
      for (int i = 0; i < 8; ++i) {
        const int row = r0 + 16 * i, m = mbase + row;
        h16* q = X1 + (size_t)m * DM + n;
        const F8 a = ld32(T + row * 128 + c8), x = ld16(q);
        F8 o; o.a = x.a + a.a; o.b = x.b + a.b;
        st16(q, o);
      }
    }
    __syncthreads();
  }
}

constexpr int NPHASE = 11;

#define XB_TMO      128
#define XB_XCNT(j)  (256  + 64 * (j))
#define XB_XSUB(j)  (1280 + 64 * (j))
#define XB_XGEN(j)  (2304 + 64 * (j))
#define XB_TOP      3328
#define XB_TOPGEN   3392
#define XCD_BAR_WORDS 3456
#define XB_SPIN_CAP (1u << 18)
FI unsigned xb_ld(unsigned* p)              { return __hip_atomic_load(p, __ATOMIC_RELAXED, __HIP_MEMORY_SCOPE_AGENT); }
FI unsigned xb_add(unsigned* p, unsigned v) { return __hip_atomic_fetch_add(p, v, __ATOMIC_RELAXED, __HIP_MEMORY_SCOPE_AGENT); }
FI unsigned xb_xcc_id() { return (unsigned)__builtin_amdgcn_s_getreg((3 << 11) | 20) & 0xFu; }
#define XB_SPIN(cond, bar) do { unsigned _sp = 0; while (cond) { __builtin_amdgcn_s_sleep(1); \
    if ((++_sp & 255u) == 0u) { if (xb_ld(&(bar)[XB_TMO])) break; if (_sp > XB_SPIN_CAP) { atomicAdd(&(bar)[XB_TMO], 1u); break; } } } } while (0)
struct XcdBarrier { unsigned* bar; unsigned x; volatile unsigned* st; };
FI XcdBarrier xcd_barrier_post(unsigned* bar, volatile unsigned* st) {
  XcdBarrier b; b.bar = bar; b.x = xb_xcc_id(); b.st = st;
  if (threadIdx.x == 0) (void)xb_add(&bar[XB_XCNT(b.x)], 1u);
  return b;
}
FI void xcd_barrier_complete(unsigned* bar, unsigned x, unsigned& nloc, unsigned& nx) {
  const unsigned G = gridDim.x * gridDim.y * gridDim.z;
  unsigned sum, cnt, mine, sp = 0u;
  for (;;) {
    sum = 0u; cnt = 0u; mine = 0u;
#pragma unroll
    for (unsigned j = 0; j < 16; ++j) { const unsigned c = xb_ld(&bar[XB_XCNT(j)]); sum += c; cnt += (c > 0u) ? 1u : 0u; mine = (j == x) ? c : mine; }
    if (sum == G) break;
    __builtin_amdgcn_s_sleep(1);
    if ((++sp & 255u) == 0u) { if (xb_ld(&bar[XB_TMO])) break; if (sp > XB_SPIN_CAP) { atomicAdd(&bar[XB_TMO], 1u); break; } }
  }
  nloc = mine > 0u ? mine : 1u; nx = cnt > 0u ? cnt : 1u;
}
FI void xcd_barrier(const XcdBarrier& b) {
  asm volatile("s_waitcnt vmcnt(0)" ::: "memory");
  __syncthreads();
  if (threadIdx.x == 0) {
    unsigned* bar = b.bar;
    __builtin_amdgcn_s_waitcnt(0);
    unsigned nloc = b.st[0], nx = b.st[1];
    if (nloc == 0u) { xcd_barrier_complete(bar, b.x, nloc, nx); b.st[0] = nloc; b.st[1] = nx; }
    const unsigned old = xb_add(&bar[XB_XSUB(b.x)], 1u);
    const unsigned gen = old / nloc;
    if (old + 1u == (gen + 1u) * nloc) {
      __builtin_amdgcn_fence(__ATOMIC_RELEASE, "agent");
      asm volatile("s_waitcnt vmcnt(0)" ::: "memory");
      const unsigned og = xb_add(&bar[XB_TOP], 1u);
      const unsigned tg = og / nx;
      if (og + 1u == (tg + 1u) * nx) xb_add(&bar[XB_TOPGEN], 1u);
      else XB_SPIN(xb_ld(&bar[XB_TOPGEN]) == tg, bar);
      __builtin_amdgcn_fence(__ATOMIC_ACQUIRE, "agent");
      xb_add(&bar[XB_XGEN(b.x)], 1u);
      asm volatile("s_waitcnt vmcnt(0)" ::: "memory");
    } else {
      XB_SPIN(xb_ld(&bar[XB_XGEN(b.x)]) == gen, bar);
      __builtin_amdgcn_fence(__ATOMIC_ACQUIRE, "agent");
      asm volatile("s_waitcnt vmcnt(0)" ::: "memory");
    }
  }
  __syncthreads();
}

template <int PH> FI void run_phase(const Params& p, char* lds) {
  if (PH == 0) phase0(p, lds);
  if (PH == 1) phase1(p, lds);
  if (PH == 2) phaseA(p, lds);
  if (PH == 3) phase3(p, lds);
  if (PH == 4) phase3b(p, lds);
  if (PH == 5) phase4(p, lds);
  if (PH == 6) phase5(p, lds);
  if (PH == 7) rms_rows(p, 1, (const float*)(p.ws + WS_A), p.in[I_N2G], (h16*)(p.ws + WS_D), blockIdx.x * 4 + (threadIdx.x >> 6), gridDim.x * 4);
  if (PH == 8) phase7(p, lds);
  if (PH == 9) phase8(p, lds);
  if (PH == 10) rms_rows(p, 2, (const float*)(p.ws + WS_A), p.in[I_FNG], nullptr, blockIdx.x * 4 + (threadIdx.x >> 6), gridDim.x * 4);
}

template <int PH> __global__ void __launch_bounds__(256, 1) mega_one(Params p) {
  __shared__ __attribute__((aligned(16))) char lds[77824 + 16];
  run_phase<PH>(p, lds);
}

#if N_LAUNCH_MODE == 1
__global__ void __launch_bounds__(256, 2) mega(Params p) {
  __shared__ __attribute__((aligned(16))) char lds[77824 + 16];
  volatile unsigned* st = (volatile unsigned*)(lds + 77824);
  if (threadIdx.x < 4) st[threadIdx.x] = 0u;
  __syncthreads();
  if (p.ph_lo < 0) cg::this_grid().sync();
  XcdBarrier xb = xcd_barrier_post((unsigned*)(p.ws + WS_END), st);
  run_phase<0>(p, lds); xcd_barrier(xb);
  run_phase<1>(p, lds); xcd_barrier(xb);
  run_phase<2>(p, lds); xcd_barrier(xb);
  run_phase<3>(p, lds); xcd_barrier(xb);
  run_phase<4>(p, lds); xcd_barrier(xb);
  run_phase<5>(p, lds); xcd_barrier(xb);
  run_phase<6>(p, lds); xcd_barrier(xb);
  run_phase<7>(p, lds); xcd_barrier(xb);
  run_phase<8>(p, lds); xcd_barrier(xb);
  run_phase<9>(p, lds); xcd_barrier(xb);
  run_phase<10>(p, lds);
}
#endif

extern "C" void kernel_launch(void* const* d_in, const int* in_sizes, int n_in, void* d_out, int out_size,
                              void* d_ws, size_t ws_size, hipStream_t stream) {
  static int grid = 0;
  if (!grid) {
    int dev = 0, cus = 0, per_cu = 0;
    (void)hipGetDevice(&dev);
    (void)hipDeviceGetAttribute(&cus, hipDeviceAttributeMultiprocessorCount, dev);
#if N_LAUNCH_MODE == 1
    (void)hipOccupancyMaxActiveBlocksPerMultiprocessor(&per_cu, mega, 256, 0);
#else
    per_cu = 2;
#endif
    if (per_cu < 1) per_cu = 1;
    if (per_cu > 2) per_cu = 2;
    grid = cus * per_cu;
    if (ws_size < WS_RK + 1179648) fprintf(stderr, "workspace too small: %zu < %zu\n", ws_size, (size_t)WS_END);
  }
  Params p{};
  for (int i = 0; i < 30; ++i) p.in[i] = (const float*)d_in[i];
  p.out = (float*)d_out;
  p.ws = (char*)d_ws;
#if N_LAUNCH_MODE == 1
  p.ph_lo = 0; p.ph_hi = NPHASE;
  (void)hipMemsetAsync((char*)d_ws + WS_END, 0, XCD_BAR_WORDS * 4, stream);
  void* args[] = {&p};
  hipError_t e = hipLaunchCooperativeKernel((void*)mega, dim3(grid), dim3(256), args, 0, stream);
  if (e != hipSuccess) fprintf(stderr, "cooperative launch failed: %s (grid %d)\n", hipGetErrorString(e), grid);
#else
  p.ph_lo = 0; p.ph_hi = NPHASE;
  hipLaunchKernelGGL(mega_one<0>, dim3(grid), dim3(256), 0, stream, p);
  hipLaunchKernelGGL(mega_one<1>, dim3(grid), dim3(256), 0, stream, p);
  hipLaunchKernelGGL(mega_one<2>, dim3(grid), dim3(256), 0, stream, p);
  hipLaunchKernelGGL(mega_one<3>, dim3(grid), dim3(256), 0, stream, p);
  hipLaunchKernelGGL(mega_one<4>, dim3(grid), dim3(256), 0, stream, p);
  hipLaunchKernelGGL(mega_one<5>, dim3(grid), dim3(256), 0, stream, p);
  hipLaunchKernelGGL(mega_one<6>, dim3(grid), dim3(256), 0, stream, p);
  hipLaunchKernelGGL(mega_one<7>, dim3(grid), dim3(256), 0, stream, p);
  hipLaunchKernelGGL(mega_one<8>, dim3(grid), dim3(256), 0, stream, p);
  hipLaunchKernelGGL(mega_one<9>, dim3(grid), dim3(256), 0, stream, p);
  hipLaunchKernelGGL(mega_one<10>, dim3(grid), dim3(256), 0, stream, p);
#endif
}
```

```cpp
#include <hip/hip_runtime.h>
#include <hip/hip_cooperative_groups.h>
#include <stdint.h>
#include <stdio.h>
namespace cg = cooperative_groups;

#ifndef N_LAUNCH_MODE
#define N_LAUNCH_MODE 1
#endif

typedef _Float16 h16;
typedef _Float16 h16x8 __attribute__((ext_vector_type(8)));
typedef _Float16 h16x4 __attribute__((ext_vector_type(4)));
typedef float f32x16 __attribute__((ext_vector_type(16)));
typedef float f32x4 __attribute__((ext_vector_type(4)));
typedef float f32x2 __attribute__((ext_vector_type(2)));

#define FI __device__ __forceinline__

constexpr int DM = 1024;
constexpr int MTOK = 17024;
constexpr int TPR = 2064;
constexpr int NPTOK = 16512;
constexpr int RWP = 3360;
constexpr int PTOT = 8480;
constexpr int DFF = 2816;
constexpr int LAW = 320;
constexpr int NMT_H = 136;
constexpr int NMT = 133;

constexpr size_t O_YP = 0, O_YS = 16777216, O_WKV = 17301504, O_SH = 26214400, O_SC = 26671360, O_FFN = 26949888;

constexpr size_t WS_WIN = 0;
constexpr size_t WS_WA = 17563648, WS_WB = 19660800, WS_WO = 21757952;
constexpr size_t WS_WUP = 23855104, WS_WDN = 35389440;
constexpr size_t WS_WLD = 41156608, WS_WLA = 41287680, WS_WLG = 41418752;
constexpr size_t WS_B = 41811968;
constexpr size_t WS_A = 146407424;
constexpr size_t WS_C = 181272576;
constexpr size_t WS_D = 216137728;
constexpr size_t WS_E = 251002880;
constexpr size_t WS_END = 261898240;

struct Params {
  const float* in[30];
  float* out;
  char* ws;
  int ph_lo, ph_hi;
};

enum { I_XP = 0, I_XS, I_SWKV, I_SSH, I_SSC, I_SFFN, I_META, I_N1G, I_WIN, I_BG, I_MU, I_W0, I_WDEC, I_A0, I_WAAA,
       I_WGATE, I_KK, I_KA, I_RK, I_LNG, I_LNB, I_WBR, I_WBS, I_CSC, I_WOUT, I_N2G, I_WUP, I_CFFN, I_WDN, I_FNG };

FI float sigm(float x) { return __builtin_amdgcn_rcpf(1.f + __expf(-x)); }
FI float tanh_(float x) { return 1.f - 2.f * __builtin_amdgcn_rcpf(1.f + __expf(2.f * x)); }
FI float wave_sum(float v) {
#pragma unroll
  for (int o = 32; o; o >>= 1) v += __shfl_xor(v, o);
  return v;
}
FI float sum16(float v) {
#pragma unroll
  for (int o = 8; o; o >>= 1) v += __shfl_xor(v, o);
  return v;
}
FI float quad_sum(float v) {
  float t = __builtin_bit_cast(float, __builtin_amdgcn_update_dpp(0, __builtin_bit_cast(int, v), 0xB1, 0xF, 0xF, true));
  v += t;
  t = __builtin_bit_cast(float, __builtin_amdgcn_update_dpp(0, __builtin_bit_cast(int, v), 0x4E, 0xF, 0xF, true));
  return v + t;
}
struct Tok { int seq, t, T; };
FI Tok tokinfo(int m) {
  Tok k;
  if (m < NPTOK) { k.seq = m / TPR; k.t = m - k.seq * TPR; k.T = TPR; }
  else { int mm = m - NPTOK; k.seq = 8 + (mm >> 2); k.t = mm & 3; k.T = 4; }
  return k;
}
FI const float* xrow(const Params& p, int m) {
  if (m < NPTOK) {
    int s = m / TPR, t = m - s * TPR;
    return t < 16 ? p.in[I_META] + t * DM : p.in[I_XP] + ((size_t)s * 2048 + (t - 16)) * DM;
  }
  return p.in[I_XS] + (size_t)(m - NPTOK) * DM;
}

FI int swz(int row, int chunk) { return row * 128 + ((chunk ^ ((row >> 1) & 7)) << 4); }

FI void zero_acc(f32x4 (&acc)[4][4]) {
#pragma unroll
  for (int a = 0; a < 4; ++a)
#pragma unroll
    for (int b = 0; b < 4; ++b) acc[a][b] = f32x4{0.f, 0.f, 0.f, 0.f};
}

FI void mainloop(f32x4 (&acc)[4][4], const h16* __restrict__ A, int lda, int mbase,
                 const h16* __restrict__ BT, int ldb, int K, char* lds) {
  const int tid = threadIdx.x, lane = tid & 63, wave = tid >> 6, wr = wave >> 1, wc = wave & 1;
  uint32_t aoff[4], boff[4];
#pragma unroll
  for (int i = 0; i < 4; ++i) {
    const int row = wave * 32 + i * 8 + (lane >> 3);
    const int chunk = (lane & 7) ^ ((row >> 1) & 7);
    int m = mbase + row; m = m < 0 ? 0 : (m > MTOK - 1 ? MTOK - 1 : m);
    aoff[i] = (uint32_t)m * lda + chunk * 8;
    boff[i] = (uint32_t)row * ldb + chunk * 8;
  }
  const int ldsw = wave * 4096 + lane * 16;
#define ML_ISSUE(KT, BUF) do { _Pragma("unroll") for (int i = 0; i < 4; ++i) { \
    __builtin_amdgcn_global_load_lds((const unsigned*)(A + aoff[i] + (KT) * 64), (unsigned*)(lds + (BUF) * 32768 + ldsw + i * 1024), 16, 0, 0); \
    __builtin_amdgcn_global_load_lds((const unsigned*)(BT + boff[i] + (KT) * 64), (unsigned*)(lds + (BUF) * 32768 + 16384 + ldsw + i * 1024), 16, 0, 0); } } while (0)
  const int nk = K >> 6;
  const int rA0 = wr * 64 + (lane & 15), rB0 = wc * 64 + (lane & 15), hh = lane >> 4;
  ML_ISSUE(0, 0);
  for (int kt = 0; kt < nk; ++kt) {
    const int buf = kt & 1;
    asm volatile("s_waitcnt vmcnt(0)" ::: "memory");
    __syncthreads();
    if (kt + 1 < nk) ML_ISSUE(kt + 1, buf ^ 1);
    const char* la = lds + buf * 32768;
    const char* lb = la + 16384;
#pragma unroll
    for (int ks = 0; ks < 2; ++ks) {
      h16x8 a[4], b[4];
#pragma unroll
      for (int t = 0; t < 4; ++t) {
        a[t] = *(const h16x8*)(la + swz(rA0 + t * 16, ks * 4 + hh));
        b[t] = *(const h16x8*)(lb + swz(rB0 + t * 16, ks * 4 + hh));
      }
#pragma unroll
      for (int ti = 0; ti < 4; ++ti)
#pragma unroll
        for (int tj = 0; tj < 4; ++tj) acc[ti][tj] = __builtin_amdgcn_mfma_f32_16x16x32_f16(a[ti], b[tj], acc[ti][tj], 0, 0, 0);
    }
  }
  __syncthreads();
#undef ML_ISSUE
}

FI int swz32(int row, int chunk) { return row * 64 + ((chunk ^ ((0 - (row >> 2)) & 3)) << 4); }
FI void mainloop2(f32x4 (&acc)[4][4], f32x4 (&acc2)[4][4], const h16* __restrict__ A, int lda, int mbase,
                  const h16* __restrict__ BT1, const h16* __restrict__ BT2, int ldb, int K, char* lds) {
  const int tid = threadIdx.x, lane = tid & 63, wave = tid >> 6, wr = wave >> 1, wc = wave & 1;
  uint32_t aoff[2], boff[2];
#pragma unroll
  for (int i = 0; i < 2; ++i) {
    const int row = wave * 32 + i * 16 + (lane >> 2);
    const int chunk = (lane & 3) ^ ((0 - (row >> 2)) & 3);
    int m = mbase + row; m = m < 0 ? 0 : (m > MTOK - 1 ? MTOK - 1 : m);
    aoff[i] = (uint32_t)m * lda + chunk * 8;
    boff[i] = (uint32_t)row * ldb + chunk * 8;
  }
  const int ldsw = wave * 2048 + lane * 16;
#define ML2_ISSUE(KT, BUF) do { _Pragma("unroll") for (int i = 0; i < 2; ++i) { \
    __builtin_amdgcn_global_load_lds((const unsigned*)(A + aoff[i] + (KT) * 32), (unsigned*)(lds + (BUF) * 24576 + ldsw + i * 1024), 16, 0, 0); \
    __builtin_amdgcn_global_load_lds((const unsigned*)(BT1 + boff[i] + (KT) * 32), (unsigned*)(lds + (BUF) * 24576 + 8192 + ldsw + i * 1024), 16, 0, 0); \
    __builtin_amdgcn_global_load_lds((const unsigned*)(BT2 + boff[i] + (KT) * 32), (unsigned*)(lds + (BUF) * 24576 + 16384 + ldsw + i * 1024), 16, 0, 0); } } while (0)
  const int nk = K >> 5;
  const int rA0 = wr * 64 + (lane & 15), rB0 = wc * 64 + (lane & 15), hh = lane >> 4;
  ML2_ISSUE(0, 0);
  for (int kt = 0; kt < nk; ++kt) {
    const int buf = kt & 1;
    asm volatile("s_waitcnt vmcnt(0)" ::: "memory");
    __syncthreads();
    if (kt + 1 < nk) ML2_ISSUE(kt + 1, buf ^ 1);
    const char* la = lds + buf * 24576;
    const char* lb = la + 8192;
    const char* lc = la + 16384;
    {
      h16x8 a[4], b[4], c[4];
#pragma unroll
      for (int t = 0; t < 4; ++t) {
        a[t] = *(const h16x8*)(la + swz32(rA0 + t * 16, hh));
        b[t] = *(const h16x8*)(lb + swz32(rB0 + t * 16, hh));
        c[t] = *(const h16x8*)(lc + swz32(rB0 + t * 16, hh));
      }
#pragma unroll
      for (int ti = 0; ti < 4; ++ti)
#pragma unroll
        for (int tj = 0; tj < 4; ++tj) {
          acc[ti][tj] = __builtin_amdgcn_mfma_f32_16x16x32_f16(a[ti], b[tj], acc[ti][tj], 0, 0, 0);
          acc2[ti][tj] = __builtin_amdgcn_mfma_f32_16x16x32_f16(a[ti], c[tj], acc2[ti][tj], 0, 0, 0);
        }
    }
  }
  __syncthreads();
#undef ML2_ISSUE
}

#define CROW(ti, reg) (wr * 64 + (ti) * 16 + 4 * (lane >> 4) + (reg))
#define CCOL(tj) (wc * 64 + (tj) * 16 + (lane & 15))

FI void stage_acc(const f32x4 (&acc)[4][4], float* T) {
  const int tid = threadIdx.x, lane = tid & 63, wave = tid >> 6, wr = wave >> 1, wc = wave & 1;
#pragma unroll
  for (int ti = 0; ti < 4; ++ti)
#pragma unroll
    for (int tj = 0; tj < 4; ++tj)
#pragma unroll
      for (int r = 0; r < 4; ++r) T[CROW(ti, r) * 128 + CCOL(tj)] = acc[ti][tj][r];
}

FI int win_map(int dr) {
  if (dr < 3360) return dr;
  if (dr < 3456) return -1;
  if (dr < 4480) return 3360 + (dr - 3456);
  if (dr < 5504) return 5408 + (dr - 4480);
  if (dr < 6528) return 4384 + (dr - 5504);
  return 6432 + (dr - 6528);
}
FI void transpose_tile(const float* __restrict__ src, int ldsrc, int Ksrc, int Nsrc, int mode, int rt, int ktile,
                       h16* __restrict__ dst, int lddst, float* sm) {
  const int tid = threadIdx.x;
  {
    const int rr = tid & 63, kq = tid >> 6;
    const int dr = rt * 64 + rr;
    int col = mode ? win_map(dr) : (dr < Nsrc ? dr : -1);
#pragma unroll
    for (int i = 0; i < 16; ++i) {
      int kk = kq + 4 * i, k = ktile * 64 + kk;
      float v = (col >= 0 && k < Ksrc) ? src[(size_t)k * ldsrc + col] : 0.f;
      sm[kk * 65 + rr] = v;
    }
  }
  __syncthreads();
  {
    const int dr = tid >> 2, seg = tid & 3;
    h16x8 o0, o1;
#pragma unroll
    for (int j = 0; j < 8; ++j) { o0[j] = (h16)sm[(seg * 16 + j) * 65 + dr]; o1[j] = (h16)sm[(seg * 16 + 8 + j) * 65 + dr]; }
    h16* d = dst + (size_t)(rt * 64 + dr) * lddst + ktile * 64 + seg * 16;
    *(h16x8*)d = o0; *(h16x8*)(d + 8) = o1;
  }
  __syncthreads();
}

FI void rms_rows(const Params& p, int mode, const float* __restrict__ src, const float* __restrict__ g, h16* dsth, int gw, int nw) {
  const int lane = threadIdx.x & 63;
  for (int m = gw; m < MTOK; m += nw) {
    f32x4 v[4]; float ss = 0.f;
    if (mode == 0) {
      const float* row = xrow(p, m);
#pragma unroll
      for (int i = 0; i < 4; ++i) v[i] = *(const f32x4*)(row + lane * 4 + 256 * i);
    } else {
      const h16* row = (const h16*)src + (size_t)m * DM;
#pragma unroll
      for (int i = 0; i < 4; ++i) { const h16x4 h = *(const h16x4*)(row + lane * 4 + 256 * i); v[i] = f32x4{(float)h[0], (float)h[1], (float)h[2], (float)h[3]}; }
    }
#pragma unroll
    for (int i = 0; i < 4; ++i) ss += v[i].x * v[i].x + v[i].y * v[i].y + v[i].z * v[i].z + v[i].w * v[i].w;
    ss = wave_sum(ss);
    const float rs = rsqrtf(ss * (1.f / DM) + 1e-6f);
    if (mode == 2) {
      float* o;
      if (m < NPTOK) { int s = m / TPR, t = m - s * TPR; if (t < 16) continue; o = p.out + O_YP + ((size_t)s * 2048 + (t - 16)) * DM; }
      else o = p.out + O_YS + (size_t)(m - NPTOK) * DM;
#pragma unroll
      for (int i = 0; i < 4; ++i) { f32x4 gg = *(const f32x4*)(g + lane * 4 + 256 * i); f32x4 r = v[i] * rs * gg; *(f32x4*)(o + lane * 4 + 256 * i) = r; }
    } else {
#pragma unroll
      for (int i = 0; i < 4; ++i) {
        f32x4 gg = *(const f32x4*)(g + lane * 4 + 256 * i); f32x4 r = v[i] * rs * gg;
        h16x4 h; h[0] = (h16)r.x; h[1] = (h16)r.y; h[2] = (h16)r.z; h[3] = (h16)r.w;
        *(h16x4*)(dsth + (size_t)m * DM + lane * 4 + 256 * i) = h;
      }
    }
  }
}

FI void transpose_item(const Params& p, float* sm, int it) {
  {
    int i = it;
    if (i < 2144) { transpose_tile(p.in[I_WIN], PTOT, 1024, PTOT, 1, i >> 4, i & 15, (h16*)(p.ws + WS_WIN), 1024, sm); return; }
    i -= 2144;
    if (i < 256) { transpose_tile(p.in[I_WBR], 1024, 1024, 1024, 0, i >> 4, i & 15, (h16*)(p.ws + WS_WA), 1024, sm); return; }
    i -= 256;
    if (i < 256) { transpose_tile(p.in[I_WBS], 1024, 1024, 1024, 0, i >> 4, i & 15, (h16*)(p.ws + WS_WB), 1024, sm); return; }
    i -= 256;
    if (i < 256) { transpose_tile(p.in[I_WOUT], 1024, 1024, 1024, 0, i >> 4, i & 15, (h16*)(p.ws + WS_WO), 1024, sm); return; }
    i -= 256;
    if (i < 1408) { transpose_tile(p.in[I_WUP], 5632, 1024, 5632, 0, i >> 4, i & 15, (h16*)(p.ws + WS_WUP), 1024, sm); return; }
    i -= 1408;
    if (i < 704) { transpose_tile(p.in[I_WDN], 1024, 2816, 1024, 0, i / 44, i % 44, (h16*)(p.ws + WS_WDN), 2816, sm); return; }
    i -= 704;
    if (i < 16) { transpose_tile(p.in[I_WDEC], 1024, 64, 1024, 0, i, 0, (h16*)(p.ws + WS_WLD), 64, sm); return; }
    i -= 16;
    if (i < 16) { transpose_tile(p.in[I_WAAA], 1024, 64, 1024, 0, i, 0, (h16*)(p.ws + WS_WLA), 64, sm); return; }
    i -= 16;
    transpose_tile(p.in[I_WGATE], 1024, 160, 1024, 0, i / 3, i % 3, (h16*)(p.ws + WS_WLG), 192, sm);
  }
}

FI void phase0(const Params& p, char* lds) {
  float* sm = (float*)lds;
  h16* ws = (h16*)p.ws;
  for (int it = blockIdx.x; it < 2144 + 80; it += gridDim.x) transpose_item(p, sm, it < 2144 ? it : it + 2880);
  (void)ws;
  rms_rows(p, 0, nullptr, p.in[I_N1G], (h16*)(p.ws + WS_A), blockIdx.x * 4 + (threadIdx.x >> 6), gridDim.x * 4);
}

struct F8 { f32x4 a, b; };
FI F8 ld16(const h16* q) { h16x8 v = *(const h16x8*)q; F8 r; r.a = f32x4{(float)v[0], (float)v[1], (float)v[2], (float)v[3]}; r.b = f32x4{(float)v[4], (float)v[5], (float)v[6], (float)v[7]}; return r; }
FI F8 ld32(const float* q) { F8 r; r.a = *(const f32x4*)q; r.b = *(const f32x4*)(q + 4); return r; }
FI F8 zero8() { F8 r; r.a = f32x4{0.f, 0.f, 0.f, 0.f}; r.b = r.a; return r; }
FI void st16(h16* q, const F8& v) { h16x8 h; h[0] = (h16)v.a.x; h[1] = (h16)v.a.y; h[2] = (h16)v.a.z; h[3] = (h16)v.a.w; h[4] = (h16)v.b.x; h[5] = (h16)v.b.y; h[6] = (h16)v.b.z; h[7] = (h16)v.b.w; *(h16x8*)q = h; }
FI void st32(float* q, const F8& v) { *(f32x4*)q = v.a; *(f32x4*)(q + 4) = v.b; }
FI void stage16(const f32x4 (&acc)[4][4], h16* T) {
  const int tid = threadIdx.x, lane = tid & 63, wave = tid >> 6, wr = wave >> 1, wc = wave & 1;
#pragma unroll
  for (int ti = 0; ti < 4; ++ti)
#pragma unroll
    for (int tj = 0; tj < 4; ++tj)
#pragma unroll
      for (int r = 0; r < 4; ++r) T[CROW(ti, r) * 128 + CCOL(tj)] = (h16)acc[ti][tj][r];
}
typedef _Float16 h16x2 __attribute__((ext_vector_type(2)));
FI void pack_acc(const f32x4 (&acc)[4][4], uint32_t (&pk)[4][4][2]) {
#pragma unroll
  for (int ti = 0; ti < 4; ++ti)
#pragma unroll
    for (int tj = 0; tj < 4; ++tj)
#pragma unroll
      for (int r = 0; r < 4; r += 2) {
        h16x2 h2; h2[0] = (h16)acc[ti][tj][r]; h2[1] = (h16)acc[ti][tj][r + 1];
        pk[ti][tj][r >> 1] = __builtin_bit_cast(uint32_t, h2);
      }
}
FI void stage16_pk(const uint32_t (&pk)[4][4][2], h16* T) {
  const int tid = threadIdx.x, lane = tid & 63, wave = tid >> 6, wr = wave >> 1, wc = wave & 1;
#pragma unroll
  for (int ti = 0; ti < 4; ++ti)
#pragma unroll
    for (int tj = 0; tj < 4; ++tj)
#pragma unroll
      for (int r = 0; r < 4; r += 2) {
        h16x2 h2 = __builtin_bit_cast(h16x2, pk[ti][tj][r >> 1]);
        T[CROW(ti, r) * 128 + CCOL(tj)] = h2[0];
        T[CROW(ti, r + 1) * 128 + CCOL(tj)] = h2[1];
      }
}
FI void conv_prev(const h16* T, int row, int c8, const Tok& k, const float* st  , int ld, F8& p1, F8& p2) {
  if (k.t >= 2) { p1 = ld16(T + (row - 1) * 128 + c8); p2 = ld16(T + (row - 2) * 128 + c8); }
  else if (k.t == 1) { p1 = ld16(T + (row - 1) * 128 + c8); p2 = k.seq >= 8 ? ld32(st + ld) : zero8(); }
  else { if (k.seq >= 8) { p1 = ld32(st + ld); p2 = ld32(st); } else { p1 = zero8(); p2 = zero8(); } }
}

FI h16x8 cvth(const F8& v) { h16x8 h; h[0] = (h16)v.a.x; h[1] = (h16)v.a.y; h[2] = (h16)v.a.z; h[3] = (h16)v.a.w; h[4] = (h16)v.b.x; h[5] = (h16)v.b.y; h[6] = (h16)v.b.z; h[7] = (h16)v.b.w; return h; }
FI F8 cvtf(const h16x8& v) { F8 r; r.a = f32x4{(float)v[0], (float)v[1], (float)v[2], (float)v[3]}; r.b = f32x4{(float)v[4], (float)v[5], (float)v[6], (float)v[7]}; return r; }
FI h16x8 zeroh() { h16x8 h; for (int i = 0; i < 8; ++i) h[i] = (h16)0.f; return h; }
FI void conv_prev16(const h16* T, int row, int c8, const Tok& k, const float* st  , int ld, h16x8& p1, h16x8& p2) {
  if (k.t >= 2) { p1 = *(const h16x8*)(T + (row - 1) * 128 + c8); p2 = *(const h16x8*)(T + (row - 2) * 128 + c8); }
  else if (k.t == 1) { p1 = *(const h16x8*)(T + (row - 1) * 128 + c8); p2 = k.seq >= 8 ? cvth(ld32(st + ld)) : zeroh(); }
  else { if (k.seq >= 8) { p1 = cvth(ld32(st + ld)); p2 = cvth(ld32(st)); } else { p1 = zeroh(); p2 = zeroh(); } }
}

FI void phase1(const Params& p, char* lds) {
  const int tid = threadIdx.x;
  const h16* XN = (const h16*)(p.ws + WS_A);
  const h16* WinT = (const h16*)(p.ws + WS_WIN);
  h16* PB = (h16*)(p.ws + WS_B);
  h16* ZB = (h16*)(p.ws + WS_C);
  h16* LA = (h16*)(p.ws + WS_E);
  const int c8 = (tid & 15) * 8, r0 = tid >> 4;
  for (int it = blockIdx.x; it < 35 * NMT_H; it += gridDim.x) {
    const int j = it / NMT_H, mt = it - j * NMT_H;
    const int mbase = mt * 126 - 2;
    {
      const int npass = j < 8 ? 3 : 1;
      uint32_t pk[4][4][2];
#pragma unroll 1
      for (int pass = 0; pass < npass; ++pass) {
        int brow;
        if (j < 8) brow = (pass == 0 ? 3456 : (pass == 1 ? 4480 : 5504)) + j * 128;
        else brow = (j - 8) * 128;
        f32x4 acc[4][4];
        zero_acc(acc);
        mainloop(acc, XN, DM, mbase, WinT + (size_t)brow * DM, DM, DM, lds);
        if (j < 8) {
          if (pass == 0) pack_acc(acc, pk);
          else if (pass == 1) {
#pragma unroll
            for (int ti = 0; ti < 4; ++ti)
#pragma unroll
              for (int tj = 0; tj < 4; ++tj)
#pragma unroll
                for (int r = 0; r < 4; r += 2) {
                  h16x2 h2 = __builtin_bit_cast(h16x2, pk[ti][tj][r >> 1]);
                  h2[0] = (h16)((float)h2[0] * acc[ti][tj][r]); h2[1] = (h16)((float)h2[1] * acc[ti][tj][r + 1]);
                  pk[ti][tj][r >> 1] = __builtin_bit_cast(uint32_t, h2);
                }
          } else { stage16_pk(pk, (h16*)lds); stage16(acc, (h16*)lds + 16384); }
        } else stage_acc(acc, (float*)lds);
      }
    }
    if (j < 8) {
      const int n0 = j * 128;
      h16* TU = (h16*)lds; h16* TB = TU + 16384;
      __syncthreads();
      const int ch = n0 + c8;
      const float* cw = p.in[I_CSC];
      const h16x8 w0 = cvth(ld32(cw + ch)), w1 = cvth(ld32(cw + 1024 + ch)), w2 = cvth(ld32(cw + 2048 + ch));
#pragma unroll 1
      for (int i = 0; i < 8; ++i) {
        const int row = r0 + 16 * i, m = mbase + row;
        if (row < 2 || m >= MTOK) continue;
        const Tok k = tokinfo(m);
        const h16x8 cur = *(const h16x8*)(TU + row * 128 + c8), bg = *(const h16x8*)(TB + row * 128 + c8);
        h16x8 p1, p2;
        conv_prev16(TU, row, c8, k, p.in[I_SSC] + (size_t)(k.seq - 8) * 2048 + ch, 1024, p1, p2);
        *(h16x8*)(ZB + (size_t)m * DM + ch) = bg * (w0 * p2 + w1 * p1 + w2 * cur);
        if (k.t >= k.T - 2) st32(p.out + O_SC + (size_t)k.seq * 2048 + (k.t - (k.T - 2)) * 1024 + ch, cvtf(cur));
      }
      __syncthreads();
    } else {
      const int n0 = (j - 8) * 128;
      float* T = (float*)lds;
      __syncthreads();
      const int n = n0 + c8;
      const F8 muv = n < RWP ? ld32(p.in[I_MU] + n) : zero8();
#pragma unroll 1
      for (int i = 0; i < 8; ++i) {
        const int row = r0 + 16 * i, m = mbase + row;
        if (row < 2 || m >= MTOK) continue;
        const Tok k = tokinfo(m);
        const F8 cur = ld32(T + row * 128 + c8);
        F8 prev;
        if (k.t >= 1) prev = ld32(T + (row - 1) * 128 + c8);
        else prev = (k.seq >= 8 && n < RWP) ? ld32(p.in[I_SSH] + (size_t)(k.seq - 8) * RWP + n) : zero8();
        F8 xs;
        xs.a = cur.a + (prev.a - cur.a) * muv.a;
        xs.b = cur.b + (prev.b - cur.b) * muv.b;
        if (n < 3072) st16(PB + (size_t)m * 3072 + n, xs);
        else {
          const int q = n - 3072;
          if (q < LAW) {
            F8 v;
            if (q < 64) { v.a = f32x4{tanh_(xs.a.x), tanh_(xs.a.y), tanh_(xs.a.z), tanh_(xs.a.w)}; v.b = f32x4{tanh_(xs.b.x), tanh_(xs.b.y), tanh_(xs.b.z), tanh_(xs.b.w)}; }
            else if (q < 128) v = xs;
            else if (q < 288) { v.a = f32x4{sigm(xs.a.x), sigm(xs.a.y), sigm(xs.a.z), sigm(xs.a.w)}; v.b = f32x4{sigm(xs.b.x), sigm(xs.b.y), sigm(xs.b.z), sigm(xs.b.w)}; }
            else v = zero8();
            st16(LA + (size_t)m * LAW + q, v);
          }
        }
        if (n < RWP && k.t == k.T - 1) st32(p.out + O_SH + (size_t)k.seq * RWP + n, cur);
      }
      __syncthreads();
    }
  }
}

template <int CTRL> FI float dpp_mov(float v) { return __builtin_bit_cast(float, __builtin_amdgcn_update_dpp(0, __builtin_bit_cast(int, v), CTRL, 0xF, 0xF, true)); }
FI float row8_sum(float v) { v += dpp_mov<0xB1>(v); v += dpp_mov<0x4E>(v); v += dpp_mov<0x141>(v); return v; }
FI float row16_sum(float v) { v = row8_sum(v); v += dpp_mov<0x140>(v); return v; }

constexpr size_t OUT_Y_BYTES = 34865152;
constexpr size_t WS_YS = WS_END + 65536;
constexpr size_t WS_RK = WS_YS + 1048576;
FI h16* yrow(const Params& p, int m) {
  return m < NPTOK ? (h16*)((char*)p.out + OUT_Y_BYTES) + (size_t)m * DM : (h16*)(p.ws + WS_YS) + (size_t)(m - NPTOK) * DM;
}

FI void phaseA(const Params& p, char* lds) {
  const int tid = threadIdx.x, lane = tid & 63, wave = tid >> 6, wr = wave >> 1, wc = wave & 1;
  const h16* LA = (const h16*)(p.ws + WS_E);
  h16* DA = (h16*)p.out;
  h16* AA = (h16*)(p.ws + WS_D);
  for (int it = blockIdx.x; it < 16 * NMT; it += gridDim.x) {
    const int j = it / NMT, mt = it - j * NMT;
    const int mbase = mt * 128, which = j >> 3, n0 = (j & 7) * 128;
    f32x4 acc[4][4];
    zero_acc(acc);
    if (which == 0) mainloop(acc, LA, LAW, mbase, (const h16*)(p.ws + WS_WLD) + (size_t)n0 * 64, 64, 64, lds);
    else mainloop(acc, LA + 64, LAW, mbase, (const h16*)(p.ws + WS_WLA) + (size_t)n0 * 64, 64, 64, lds);
    h16* dst = which == 0 ? DA : AA;
    stage_acc(acc, (float*)lds);
    __syncthreads();
    if (which == 0) {
      const float* T = (const float*)lds;
      const int ci = tid >> 5, cq = (tid & 31) * 4, n = n0 + cq;
      const f32x4 bias = *(const f32x4*)(p.in[I_W0] + n);
      f32x4 run = {1.f, 1.f, 1.f, 1.f};
#pragma unroll 1
      for (int rr = 0; rr < 16; ++rr) {
        const int row = ci * 16 + rr, m = mbase + row;
        if (m >= NPTOK && (m & 3) == 0) run = f32x4{1.f, 1.f, 1.f, 1.f};
        const f32x4 x = *(const f32x4*)(T + row * 128 + cq) + bias;
        run = run * f32x4{__expf(-0.60653066f * sigm(x.x)), __expf(-0.60653066f * sigm(x.y)), __expf(-0.60653066f * sigm(x.z)), __expf(-0.60653066f * sigm(x.w))};
        h16x4 h; h[0] = (h16)run.x; h[1] = (h16)run.y; h[2] = (h16)run.z; h[3] = (h16)run.w;
        *(h16x4*)(dst + (size_t)m * DM + n) = h;
      }
    } else {
      const float* T = (const float*)lds;
      const int c8 = (tid & 15) * 8, r0 = tid >> 4, n = n0 + c8;
      const float* w0p = p.in[I_W0]; const float* a0p = p.in[I_A0];
      const F8 bias = ld32((which == 0 ? w0p : a0p) + n);
#pragma unroll 1
      for (int i = 0; i < 8; ++i) {
        const int row = r0 + 16 * i, m = mbase + row;
        const F8 a = ld32(T + row * 128 + c8);
        const f32x4 xa = a.a + bias.a, xb = a.b + bias.b;
        F8 o;
        o.a = f32x4{sigm(xa.x), sigm(xa.y), sigm(xa.z), sigm(xa.w)}; o.b = f32x4{sigm(xb.x), sigm(xb.y), sigm(xb.z), sigm(xb.w)};
        if (which == 0) {
          o.a = f32x4{__expf(-0.60653066f * o.a.x), __expf(-0.60653066f * o.a.y), __expf(-0.60653066f * o.a.z), __expf(-0.60653066f * o.a.w)};
          o.b = f32x4{__expf(-0.60653066f * o.b.x), __expf(-0.60653066f * o.b.y), __expf(-0.60653066f * o.b.z), __expf(-0.60653066f * o.b.w)};
        }
        st16(dst + (size_t)m * DM + n, o);
      }
    }
    __syncthreads();
  }
}

FI void scan_unit(const Params& p, float* sm, int seq, int head, int half) {
  const int tid = threadIdx.x;
  const int T = seq < 8 ? TPR : 4;
  const int mseq = seq < 8 ? seq * TPR : NPTOK + (seq - 8) * 4;
  const h16* PB = (const h16*)(p.ws + WS_B);
  const h16* DA = (const h16*)p.out;
  const h16* AA = (const h16*)(p.ws + WS_D);
  const int rp = tid >> 4, cb = tid & 15;
  const int chp = head * 64 + cb * 4;
  const int row0 = half * 32 + rp * 2;
  f32x2 S0a, S0b, S1a, S1b;
  if (seq >= 8) {
    const float* sp = p.in[I_SWKV] + ((size_t)(seq - 8) * 16 + head) * 4096 + row0 * 64 + cb * 4;
    const f32x4 u = *(const f32x4*)sp, w = *(const f32x4*)(sp + 64);
    S0a = f32x2{u.x, u.y}; S0b = f32x2{u.z, u.w}; S1a = f32x2{w.x, w.y}; S1b = f32x2{w.z, w.w};
  } else { S0a = f32x2{0.f, 0.f}; S0b = S0a; S1a = S0a; S1b = S0a; }
  const f32x4 kkc = *(const f32x4*)(p.in[I_KK] + chp), kac = *(const f32x4*)(p.in[I_KA] + chp), rkc = *(const f32x4*)(p.in[I_RK] + chp);
  float* RKo = (float*)(p.ws + WS_RK);
  const int nch = (T + 15) >> 4;
  h16x2* YPbase = (h16x2*)(sm + 11264);
  h16x4 Apr, Apk, Apv, Apd, Apa, Ape, Bpr, Bpk, Bpv, Bpd, Bpa, Bpe, Cpr, Cpk, Cpv, Cpd, Cpa, Cpe;
#define SC_LOAD(P, T0) do { int mp = (T0) + rp; if (mp > T - 1) mp = T - 1; const size_t mm = (size_t)(mseq + mp); \
    const h16* pp = PB + mm * 3072 + chp; P##pr = *(const h16x4*)pp; P##pk = *(const h16x4*)(pp + 1024); P##pv = *(const h16x4*)(pp + 2048); \
    P##pd = *(const h16x4*)(DA + mm * DM + chp); P##pa = *(const h16x4*)(AA + mm * DM + chp); \
    P##pe = *(const h16x4*)(DA + (mm - (rp > 0 ? 1 : 0)) * DM + chp); } while (0)
#define SC_PREP(P, BUF, T0) do { float* bb = sm + (BUF) * 5632; \
    const f32x4 r4 = {(float)P##pr[0], (float)P##pr[1], (float)P##pr[2], (float)P##pr[3]}; \
    const f32x4 k4 = {(float)P##pk[0], (float)P##pk[1], (float)P##pk[2], (float)P##pk[3]}; \
    const f32x4 v4 = {(float)P##pv[0], (float)P##pv[1], (float)P##pv[2], (float)P##pv[3]}; \
    const f32x4 lam = {(float)P##pd[0], (float)P##pd[1], (float)P##pd[2], (float)P##pd[3]}; \
    f32x4 lam1 = {(float)P##pe[0], (float)P##pe[1], (float)P##pe[2], (float)P##pe[3]}; \
    if (rp == 0) lam1 = f32x4{1.f, 1.f, 1.f, 1.f}; \
    const f32x4 linv = f32x4{__builtin_amdgcn_rcpf(lam.x), __builtin_amdgcn_rcpf(lam.y), __builtin_amdgcn_rcpf(lam.z), __builtin_amdgcn_rcpf(lam.w)}; \
    const f32x4 a4 = {(float)P##pa[0], (float)P##pa[1], (float)P##pa[2], (float)P##pa[3]}; \
    const f32x4 kkv = k4 * kkc; \
    const float ss = row16_sum(kkv.x * kkv.x + kkv.y * kkv.y + kkv.z * kkv.z + kkv.w * kkv.w); \
    const f32x4 kk = kkv * __builtin_amdgcn_rcpf(fmaxf(__builtin_amdgcn_sqrtf(ss), 1e-12f)); \
    const int o = rp * 64 + cb * 4; \
      \
    const f32x4 kp_ = k4 * (1.f + (a4 - 1.f) * kac); \
    { const f32x4 rk4_ = r4 * kp_ * rkc; const float rks_ = row16_sum((rk4_.x + rk4_.y) + (rk4_.z + rk4_.w)); \
      if (half == 0 && cb == 0 && (T0) + rp < T) RKo[(size_t)(mseq + (T0) + rp) * 16 + head] = rks_; } \
    *(f32x4*)(bb + o) = r4 * lam; *(f32x4*)(bb + 1024 + o) = lam; *(f32x4*)(bb + 2048 + o) = kp_ * linv; \
    if ((cb >> 3) == half) *(f32x4*)(bb + 5120 + rp * 32 + (cb & 7) * 4) = v4;     \
    *(f32x4*)(bb + 3072 + o) = -kk * lam1; *(f32x4*)(bb + 4096 + o) = kk * a4 * linv; } while (0)
#define ST_LOAD(X, TT) do { const float* q_ = bb + (TT) * 64 + cb * 4; \
    X##a = *(const f32x4*)(q_ + 3072); X##b = *(const f32x4*)(q_ + 4096); \
    X##k = *(const f32x4*)(q_ + 2048); X##r = *(const f32x4*)q_; X##v = *(const f32x2*)(bb + 5120 + (TT) * 32 + rp * 2); } while (0)
#define LO(v) f32x2{(v).x, (v).y}
#define HI(v) f32x2{(v).z, (v).w}
#define ST_COMP(X, TT) do { \
    f32x2 s0_ = S0a * LO(X##a), s1_ = S1a * LO(X##a); s0_ = S0b * HI(X##a) + s0_; s1_ = S1b * HI(X##a) + s1_; \
    const f32x2 v0_ = {X##v.x, X##v.x}, v1_ = {X##v.y, X##v.y}; \
    const f32x2 u0a_ = LO(X##k) * v0_ + S0a, u0b_ = HI(X##k) * v0_ + S0b; \
    const f32x2 u1a_ = LO(X##k) * v1_ + S1a, u1b_ = HI(X##k) * v1_ + S1b; \
    const float sa0_ = row16_sum(s0_.x + s0_.y), sa1_ = row16_sum(s1_.x + s1_.y); \
    const f32x2 q0_ = {sa0_, sa0_}, q1_ = {sa1_, sa1_}; \
    S0a = LO(X##b) * q0_ + u0a_; S0b = HI(X##b) * q0_ + u0b_; S1a = LO(X##b) * q1_ + u1a_; S1b = HI(X##b) * q1_ + u1b_; \
    f32x2 y0_ = S0a * LO(X##r), y1_ = S1a * LO(X##r); y0_ = S0b * HI(X##r) + y0_; y1_ = S1b * HI(X##r) + y1_; \
    { h16x2 yp_; yp_[0] = (h16)(y0_.x + y0_.y); yp_[1] = (h16)(y1_.x + y1_.y); YP[(TT) * 256 + tid] = yp_; } } while (0)
#define SC_BODY(c, LSET, PSET) do { \
    const int t0 = (c) * 16; \
    const int nt = (T - t0) < 16 ? (T - t0) : 16;       \
    const float* bb = sm + ((c) & 1) * 5632; \
    h16x2* YP = YPbase + ((c) & 1) * 4096; \
    if ((c) + 3 < nch) SC_LOAD(LSET, t0 + 48); \
    if ((c) > 0) SC_YRED((c) - 1, 16); \
    { \
      f32x4 Aa, Ab, Ak, Ar; f32x2 Av; \
      f32x4 Ba, Bb, Bk, Br; f32x2 Bv; \
      ST_LOAD(A, 0); \
      for (int tt = 0; tt < nt; tt += 2) { \
        ST_LOAD(B, tt + 1); \
        ST_COMP(A, tt); \
        const int tn = tt + 2 < nt ? tt + 2 : tt; \
        ST_LOAD(A, tn); \
        ST_COMP(B, tt + 1); \
      } \
    } \
    {   \
      const f32x4 ll_ = *(const f32x4*)(bb + 1024 + (nt - 1) * 64 + cb * 4); \
      S0a = S0a * LO(ll_); S0b = S0b * HI(ll_); S1a = S1a * LO(ll_); S1b = S1b * HI(ll_); } \
    if ((c) + 1 < nch) SC_PREP(PSET, ((c) + 1) & 1, t0 + 16);     \
    __syncthreads(); } while (0)
#define SC_YRED(CC, NT) do { if (rp < (NT)) { \
      const uint4* q_ = (const uint4*)(YPbase + ((CC) & 1) * 4096 + rp * 256 + cb * 16); \
      float a0_ = 0.f, a1_ = 0.f; \
      _Pragma("unroll") for (int e_ = 0; e_ < 4; ++e_) { \
        const uint4 w_ = q_[e_]; \
        const h16x2 p0_ = __builtin_bit_cast(h16x2, w_.x), p1_ = __builtin_bit_cast(h16x2, w_.y), p2_ = __builtin_bit_cast(h16x2, w_.z), p3_ = __builtin_bit_cast(h16x2, w_.w); \
        a0_ += ((float)p0_[0] + (float)p1_[0]) + ((float)p2_[0] + (float)p3_[0]); \
        a1_ += ((float)p0_[1] + (float)p1_[1]) + ((float)p2_[1] + (float)p3_[1]); \
      } \
      h16x2 yh; yh[0] = (h16)a0_; yh[1] = (h16)a1_; \
      *(h16x2*)(yrow(p, mseq + (CC) * 16 + rp) + head * 64 + half * 32 + cb * 2) = yh; } } while (0)
  SC_LOAD(A, 0);
  if (nch > 1) { SC_LOAD(B, 16); SC_LOAD(C, 32); }
  SC_PREP(A, 0, 0);
  __syncthreads();
  for (int c = 0; c < nch; c += 3) {
    SC_BODY(c, A, B);
    if (c + 1 < nch) SC_BODY(c + 1, B, C);
    if (c + 2 < nch) SC_BODY(c + 2, C, A);
  }
#undef SC_BODY
  SC_YRED(nch - 1, T - (nch - 1) * 16);
#undef SC_YRED
  {
    float* op = p.out + O_WKV + ((size_t)seq * 16 + head) * 4096 + row0 * 64 + cb * 4;
    *(f32x4*)op = f32x4{S0a.x, S0a.y, S0b.x, S0b.y}; *(f32x4*)(op + 64) = f32x4{S1a.x, S1a.y, S1b.x, S1b.y};
  }
  __syncthreads();
#undef SC_LOAD
#undef SC_PREP
#undef ST_LOAD
#undef ST_COMP
#undef LO
#undef HI
}

FI void phase3(const Params& p, char* lds) {
  float* sm = (float*)lds;
  const int G = gridDim.x, b = blockIdx.x;
  for (int u = b; u < 256; u += G) scan_unit(p, sm, u >> 5, (u >> 1) & 15, u & 1);
  if (G > 256) {
    if (b >= 256) {
      for (int u = b - 256; u < 4096; u += G - 256) scan_unit(p, sm, 8 + (u >> 5), (u >> 1) & 15, u & 1);
      for (int it = 2144 + (b - 256); it < 5024; it += G - 256) transpose_item(p, sm, it);
    }
  }
  else {
    for (int u = b; u < 4096; u += G) scan_unit(p, sm, 8 + (u >> 5), (u >> 1) & 15, u & 1);
    for (int it = 2144 + b; it < 5024; it += G) transpose_item(p, sm, it);
  }
}

FI void phase3b(const Params& p, char* lds) {
  const int tid = threadIdx.x;
  const h16* LA = (const h16*)(p.ws + WS_E);
  const h16* PB = (const h16*)(p.ws + WS_B);
  h16* AZ = (h16*)(p.ws + WS_D);
  const float* RK = (const float*)(p.ws + WS_RK);
  h16* TG = (h16*)lds;
  const int c8 = (tid & 15) * 8, r0 = tid >> 4;
  for (int it = blockIdx.x; it < 8 * NMT; it += gridDim.x) {
    const int j = it / NMT, mt = it - j * NMT;
    const int mbase = mt * 128, n0 = j * 128;
    {
      f32x4 acc[4][4];
      zero_acc(acc);
      mainloop(acc, LA + 128, LAW, mbase, (const h16*)(p.ws + WS_WLG) + (size_t)n0 * 192, 192, 192, lds);
      stage16(acc, TG);
    }
    __syncthreads();
    const int ch = n0 + c8;
    const F8 lg = ld32(p.in[I_LNG] + ch), lb = ld32(p.in[I_LNB] + ch);
#pragma unroll 1
    for (int i = 0; i < 8; ++i) {
      const int row = r0 + 16 * i, m = mbase + row;
      const F8 y = ld16(yrow(p, m) + ch);
      const F8 v = ld16(PB + (size_t)m * 3072 + 2048 + ch);
      const F8 g = ld16(TG + row * 128 + c8);
      const float rk = RK[(size_t)m * 16 + (ch >> 6)];
      const f32x4 ys = y.a + y.b;
      const float mean = row8_sum((ys.x + ys.y) + (ys.z + ys.w)) * (1.f / 64.f);
      F8 d; d.a = y.a - mean; d.b = y.b - mean;
      const f32x4 d2 = d.a * d.a + d.b * d.b;
      const float var = row8_sum((d2.x + d2.y) + (d2.z + d2.w)) * (1.f / 64.f);
      const float rs = rsqrtf(var + 64e-5f);
      F8 z;
      z.a = (d.a * rs * lg.a + lb.a + v.a * rk) * g.a;
      z.b = (d.b * rs * lg.b + lb.b + v.b * rk) * g.b;
      st16(AZ + (size_t)m * DM + ch, z);
    }
    __syncthreads();
  }
}

FI void phase4(const Params& p, char* lds) {
  const int tid = threadIdx.x;
  const h16* XN = (const h16*)(p.ws + WS_A);
  const h16* ZA = (const h16*)(p.ws + WS_D);
  const h16* ZB = (const h16*)(p.ws + WS_C);
  const h16* WinT = (const h16*)(p.ws + WS_WIN);
  const h16* WA = (const h16*)(p.ws + WS_WA);
  const h16* WB = (const h16*)(p.ws + WS_WB);
  h16* MG = (h16*)(p.ws + WS_B);
  h16* G2 = (h16*)(p.ws + WS_B + OUT_Y_BYTES);
  h16* T0 = (h16*)lds; h16* T1 = T0 + 16384;
  const int c8 = (tid & 15) * 8, r0 = tid >> 4;
  for (int it = blockIdx.x; it < 8 * NMT; it += gridDim.x) {
    const int j = it / NMT, mt = it - j * NMT;
    const int mbase = mt * 128, n0 = j * 128, n = n0 + c8;
    {
      f32x4 acc[4][4], acc2[4][4];
      zero_acc(acc); zero_acc(acc2);
      mainloop2(acc, acc2, XN, DM, mbase, WinT + (size_t)(6528 + n0) * DM, WinT + (size_t)(7552 + n0) * DM, DM, DM, lds);
      stage16(acc, T0); stage16(acc2, T1);
    }
    __syncthreads();
    {
      const F8 ba = ld32(p.in[I_BG] + n), bb = ld32(p.in[I_BG] + 1024 + n);
#pragma unroll 1
      for (int i = 0; i < 8; ++i) {
        const int row = r0 + 16 * i; const size_t o = (size_t)(mbase + row) * DM + n;
        const F8 a = ld16(T0 + row * 128 + c8), b = ld16(T1 + row * 128 + c8);
        const f32x4 xa = a.a + ba.a, xb = a.b + ba.b, ya = b.a + bb.a, yb = b.b + bb.b;
        F8 ga, gb;
        ga.a = f32x4{sigm(xa.x), sigm(xa.y), sigm(xa.z), sigm(xa.w)}; ga.b = f32x4{sigm(xb.x), sigm(xb.y), sigm(xb.z), sigm(xb.w)};
        gb.a = f32x4{sigm(ya.x), sigm(ya.y), sigm(ya.z), sigm(ya.w)}; gb.b = f32x4{sigm(yb.x), sigm(yb.y), sigm(yb.z), sigm(yb.w)};
        st16(MG + o, ga); st16(G2 + o, gb);
      }
    }
    __syncthreads();
  }
  for (int it = blockIdx.x; it < 8 * NMT; it += gridDim.x) {
    const int j = it / NMT, mt = it - j * NMT;
    const int mbase = mt * 128, n0 = j * 128, n = n0 + c8;
    {
      uint32_t pk[4][4][2];
#pragma unroll 1
      for (int pass = 0; pass < 2; ++pass) {
        f32x4 acc[4][4];
        zero_acc(acc);
        mainloop(acc, pass == 0 ? ZA : ZB, DM, mbase, (pass == 0 ? WA : WB) + (size_t)n0 * DM, DM, DM, lds);
        if (pass == 0) pack_acc(acc, pk);
        else { stage16_pk(pk, T0); stage16(acc, T1); }
      }
    }
    __syncthreads();
#pragma unroll 1
    for (int i = 0; i < 8; ++i) {
      const int row = r0 + 16 * i; const size_t o = (size_t)(mbase + row) * DM + n;
      const h16x8 oa = *(const h16x8*)(T0 + row * 128 + c8), ob = *(const h16x8*)(T1 + row * 128 + c8);
      const h16x8 ga = *(const h16x8*)(MG + o), gb = *(const h16x8*)(G2 + o);
      *(h16x8*)(MG + o) = ga * oa + gb * ob;
    }
    __syncthreads();
  }
}

FI void phase5(const Params& p, char* lds) {
  const int tid = threadIdx.x, lane = tid & 63, wave = tid >> 6, wr = wave >> 1, wc = wave & 1;
  const h16* MG = (const h16*)(p.ws + WS_B);
  const h16* WO = (const h16*)(p.ws + WS_WO);
  h16* X1 = (h16*)(p.ws + WS_A);
  for (int it = blockIdx.x; it < 8 * NMT; it += gridDim.x) {
    const int j = it / NMT, mt = it - j * NMT;
    const int mbase = mt * 128, n0 = j * 128;
    f32x4 acc[4][4];
    zero_acc(acc);
    mainloop(acc, MG, DM, mbase, WO + (size_t)n0 * DM, DM, DM, lds);
    stage_acc(acc, (float*)lds);
    __syncthreads();
    {
      const float* T = (const float*)lds;
      const int c8 = (tid & 15) * 8, r0 = tid >> 4, n = n0 + c8;
#pragma unroll 1
      for (int i = 0; i < 8; ++i) {
        const int row = r0 + 16 * i, m = mbase + row;
        const F8 a = ld32(T + row * 128 + c8), x = ld32(xrow(p, m) + n);
        F8 o; o.a = x.a + a.a; o.b = x.b + a.b;
        st16(X1 + (size_t)m * DM + n, o);
      }
    }
    __syncthreads();
  }
}

FI void phase7(const Params& p, char* lds) {
  const int tid = threadIdx.x;
  const h16* XN2 = (const h16*)(p.ws + WS_D);
  const h16* WUP = (const h16*)(p.ws + WS_WUP);
  h16* HH = (h16*)(p.ws + WS_B);
  h16* TG = (h16*)lds; h16* TV = TG + 16384;
  const int c8 = (tid & 15) * 8, r0 = tid >> 4;
  for (int it = blockIdx.x; it < 22 * NMT_H; it += gridDim.x) {
    const int j = it / NMT_H, mt = it - j * NMT_H;
    const int mbase = mt * 126 - 2, n0 = j * 128;
    {
      f32x4 acc[4][4], acc2[4][4];
      zero_acc(acc); zero_acc(acc2);
      mainloop2(acc, acc2, XN2, DM, mbase, WUP + (size_t)n0 * DM, WUP + (size_t)(DFF + n0) * DM, DM, DM, lds);
      stage16(acc, TG); stage16(acc2, TV);
    }
    __syncthreads();
    const int cgc = n0 + c8, cvc = DFF + n0 + c8;
    const float* cw = p.in[I_CFFN];
    const h16x8 g0 = cvth(ld32(cw + cgc)), g1 = cvth(ld32(cw + 5632 + cgc)), g2 = cvth(ld32(cw + 11264 + cgc));
    const h16x8 v0 = cvth(ld32(cw + cvc)), v1 = cvth(ld32(cw + 5632 + cvc)), v2 = cvth(ld32(cw + 11264 + cvc));
#pragma unroll 1
    for (int i = 0; i < 8; ++i) {
      const int row = r0 + 16 * i, m = mbase + row;
      if (row < 2 || m >= MTOK) continue;
      const Tok k = tokinfo(m);
      const h16x8 gc = *(const h16x8*)(TG + row * 128 + c8), vc = *(const h16x8*)(TV + row * 128 + c8);
      h16x8 gp1, gp2, vp1, vp2;
      const float* st = p.in[I_SFFN] + (size_t)(k.seq - 8) * 11264;
      conv_prev16(TG, row, c8, k, st + cgc, 5632, gp1, gp2);
      conv_prev16(TV, row, c8, k, st + cvc, 5632, vp1, vp2);
      const h16x8 cgh = g0 * gp2 + g1 * gp1 + g2 * gc;
      const h16x8 cvh = v0 * vp2 + v1 * vp1 + v2 * vc;
      const F8 cg_ = cvtf(cgh);
      F8 sl;
      sl.a = f32x4{cg_.a.x * sigm(cg_.a.x), cg_.a.y * sigm(cg_.a.y), cg_.a.z * sigm(cg_.a.z), cg_.a.w * sigm(cg_.a.w)};
      sl.b = f32x4{cg_.b.x * sigm(cg_.b.x), cg_.b.y * sigm(cg_.b.y), cg_.b.z * sigm(cg_.b.z), cg_.b.w * sigm(cg_.b.w)};
      *(h16x8*)(HH + (size_t)m * DFF + n0 + c8) = cvth(sl) * cvh;
      if (k.t >= k.T - 2) {
        float* fo = p.out + O_FFN + (size_t)k.seq * 11264 + (k.t - (k.T - 2)) * 5632;
        st32(fo + cgc, cvtf(gc)); st32(fo + cvc, cvtf(vc));
      }
    }
    __syncthreads();
  }
}

FI void phase8_epi(h16* X1, const h16* T, int mbase, int n0) {
  const int tid = threadIdx.x, c8 = (tid & 15) * 8, r0 = tid >> 4, n = n0 + c8;
#pragma unroll 1
  for (int i = 0; i < 8; ++i) {
    const int row = r0 + 16 * i, m = mbase + row;
    h16* q = X1 + (size_t)m * DM + n;
    const F8 a = ld16(T + row * 128 + c8), x = ld16(q);
    F8 o; o.a = x.a + a.a; o.b = x.b + a.b;
    st16(q, o);
  }
}
FI void phase8(const Params& p, char* lds) {
  const h16* HH = (const h16*)(p.ws + WS_B);
  const h16* WDN = (const h16*)(p.ws + WS_WDN);
  h16* X1 = (h16*)(p.ws + WS_A);
  h16* T0 = (h16*)lds; h16* T1 = T0 + 16384;
  const int G = gridDim.x, NP = 4 * NMT;
  const int nfull = (NP / G) * G;
  for (int it = blockIdx.x; it < nfull; it += G) {
    const int jp = it / NMT, mt = it - jp * NMT;
    const int mbase = mt * 128, n0 = jp * 256;
    {
      f32x4 acc[4][4], acc2[4][4];
      zero_acc(acc); zero_acc(acc2);
      mainloop2(acc, acc2, HH, DFF, mbase, WDN + (size_t)n0 * DFF, WDN + (size_t)(n0 + 128) * DFF, DFF, DFF, lds);
      stage16(acc, T0); stage16(acc2, T1);
    }
    __syncthreads();
    phase8_epi(X1, T0, mbase, n0);
    phase8_epi(X1, T1, mbase, n0 + 128);
    __syncthreads();
  }
  const int nrest = (NP - nfull) * 2;
  for (int w = blockIdx.x; w < nrest; w += G) {
    const int it = nfull + (w >> 1);
    const int jp = it / NMT, mt = it - jp * NMT;
    const int mbase = mt * 128, n0 = jp * 256 + (w & 1) * 128;
    {
      f32x4 acc[4][4];
      zero_acc(acc);
      mainloop(acc, HH, DFF, mbase, WDN + (size_t)n0 * DFF, DFF, DFF, lds);
      stage16(acc, T0);
    }
    __syncthreads();
    phase8_epi(X1, T0, mbase, n0);
    __syncthreads();
  }
}

constexpr int NPHASE = 11;

#define XB_TMO      128
#define XB_XCNT(j)  (256  + 64 * (j))
#define XB_XSUB(j)  (1280 + 64 * (j))
#define XB_XGEN(j)  (2304 + 64 * (j))
#define XB_TOP      3328
#define XB_TOPGEN   3392
#define XCD_BAR_WORDS 3456
#define XB_SPIN_CAP (1u << 18)
FI unsigned xb_ld(unsigned* p)              { return __hip_atomic_load(p, __ATOMIC_RELAXED, __HIP_MEMORY_SCOPE_AGENT); }
FI unsigned xb_add(unsigned* p, unsigned v) { return __hip_atomic_fetch_add(p, v, __ATOMIC_RELAXED, __HIP_MEMORY_SCOPE_AGENT); }
FI unsigned xb_xcc_id() { return (unsigned)__builtin_amdgcn_s_getreg((3 << 11) | 20) & 0xFu; }
#define XB_SPIN(cond, bar) do { unsigned _sp = 0; while (cond) { __builtin_amdgcn_s_sleep(1); \
    if ((++_sp & 255u) == 0u) { if (xb_ld(&(bar)[XB_TMO])) break; if (_sp > XB_SPIN_CAP) { atomicAdd(&(bar)[XB_TMO], 1u); break; } } } } while (0)
struct XcdBarrier { unsigned* bar; unsigned x; volatile unsigned* st; };
FI XcdBarrier xcd_barrier_post(unsigned* bar, volatile unsigned* st) {
  XcdBarrier b; b.bar = bar; b.x = xb_xcc_id(); b.st = st;
  if (threadIdx.x == 0) (void)xb_add(&bar[XB_XCNT(b.x)], 1u);
  return b;
}
FI void xcd_barrier_complete(unsigned* bar, unsigned x, unsigned& nloc, unsigned& nx) {
  const unsigned G = gridDim.x * gridDim.y * gridDim.z;
  unsigned sum, cnt, mine, sp = 0u;
  for (;;) {
    sum = 0u; cnt = 0u; mine = 0u;
#pragma unroll
    for (unsigned j = 0; j < 16; ++j) { const unsigned c = xb_ld(&bar[XB_XCNT(j)]); sum += c; cnt += (c > 0u) ? 1u : 0u; mine = (j == x) ? c : mine; }
    if (sum == G) break;
    __builtin_amdgcn_s_sleep(1);
    if ((++sp & 255u) == 0u) { if (xb_ld(&bar[XB_TMO])) break; if (sp > XB_SPIN_CAP) { atomicAdd(&bar[XB_TMO], 1u); break; } }
  }
  nloc = mine > 0u ? mine : 1u; nx = cnt > 0u ? cnt : 1u;
}
FI void xcd_barrier(const XcdBarrier& b) {
  asm volatile("s_waitcnt vmcnt(0)" ::: "memory");
  __syncthreads();
  if (threadIdx.x == 0) {
    unsigned* bar = b.bar;
    __builtin_amdgcn_s_waitcnt(0);
    unsigned nloc = b.st[0], nx = b.st[1];
    if (nloc == 0u) { xcd_barrier_complete(bar, b.x, nloc, nx); b.st[0] = nloc; b.st[1] = nx; }
    const unsigned old = xb_add(&bar[XB_XSUB(b.x)], 1u);
    const unsigned gen = old / nloc;
    if (old + 1u == (gen + 1u) * nloc) {
      __builtin_amdgcn_fence(__ATOMIC_RELEASE, "agent");
      asm volatile("s_waitcnt vmcnt(0)" ::: "memory");
      const unsigned og = xb_add(&bar[XB_TOP], 1u);
      const unsigned tg = og / nx;
      if (og + 1u == (tg + 1u) * nx) xb_add(&bar[XB_TOPGEN], 1u);
      else XB_SPIN(xb_ld(&bar[XB_TOPGEN]) == tg, bar);
      __builtin_amdgcn_fence(__ATOMIC_ACQUIRE, "agent");
      xb_add(&bar[XB_XGEN(b.x)], 1u);
      asm volatile("s_waitcnt vmcnt(0)" ::: "memory");
    } else {
      XB_SPIN(xb_ld(&bar[XB_XGEN(b.x)]) == gen, bar);
      __builtin_amdgcn_fence(__ATOMIC_ACQUIRE, "agent");
      asm volatile("s_waitcnt vmcnt(0)" ::: "memory");
    }
  }
  __syncthreads();
}

template <int PH> FI void run_phase(const Params& p, char* lds) {
  if (PH == 0) phase0(p, lds);
  if (PH == 1) phase1(p, lds);
  if (PH == 2) phaseA(p, lds);
  if (PH == 3) phase3(p, lds);
  if (PH == 4) phase3b(p, lds);
  if (PH == 5) phase4(p, lds);
  if (PH == 6) phase5(p, lds);
  if (PH == 7) rms_rows(p, 1, (const float*)(p.ws + WS_A), p.in[I_N2G], (h16*)(p.ws + WS_D), blockIdx.x * 4 + (threadIdx.x >> 6), gridDim.x * 4);
  if (PH == 8) phase7(p, lds);
  if (PH == 9) phase8(p, lds);
  if (PH == 10) rms_rows(p, 2, (const float*)(p.ws + WS_A), p.in[I_FNG], nullptr, blockIdx.x * 4 + (threadIdx.x >> 6), gridDim.x * 4);
}

template <int PH> __global__ void __launch_bounds__(256, 1) mega_one(Params p) {
  __shared__ __attribute__((aligned(16))) char lds[77824 + 16];
  run_phase<PH>(p, lds);
}

#if N_LAUNCH_MODE == 1
__global__ void __launch_bounds__(256, 2) mega(Params p) {
  __shared__ __attribute__((aligned(16))) char lds[77824 + 16];
  volatile unsigned* st = (volatile unsigned*)(lds + 77824);
  if (threadIdx.x < 4) st[threadIdx.x] = 0u;
  __syncthreads();
  if (p.ph_lo < 0) cg::this_grid().sync();
  XcdBarrier xb = xcd_barrier_post((unsigned*)(p.ws + WS_END), st);
  run_phase<0>(p, lds); xcd_barrier(xb);
  run_phase<1>(p, lds); xcd_barrier(xb);
  run_phase<2>(p, lds); xcd_barrier(xb);
  run_phase<3>(p, lds); xcd_barrier(xb);
  run_phase<4>(p, lds); xcd_barrier(xb);
  run_phase<5>(p, lds); xcd_barrier(xb);
  run_phase<6>(p, lds); xcd_barrier(xb);
  run_phase<7>(p, lds); xcd_barrier(xb);
  run_phase<8>(p, lds); xcd_barrier(xb);
  run_phase<9>(p, lds); xcd_barrier(xb);
  run_phase<10>(p, lds);
}
#endif

extern "C" void kernel_launch(void* const* d_in, const int* in_sizes, int n_in, void* d_out, int out_size,
                              void* d_ws, size_t ws_size, hipStream_t stream) {
  static int grid = 0;
  if (!grid) {
    int dev = 0, cus = 0, per_cu = 0;
    (void)hipGetDevice(&dev);
    (void)hipDeviceGetAttribute(&cus, hipDeviceAttributeMultiprocessorCount, dev);
#if N_LAUNCH_MODE == 1
    (void)hipOccupancyMaxActiveBlocksPerMultiprocessor(&per_cu, mega, 256, 0);
#else
    per_cu = 2;
#endif
    if (per_cu < 1) per_cu = 1;
    if (per_cu > 2) per_cu = 2;
    grid = cus * per_cu;
    if (ws_size < WS_RK + 1179648) fprintf(stderr, "workspace too small: %zu < %zu\n", ws_size, (size_t)WS_END);
  }
  Params p{};
  for (int i = 0; i < 30; ++i) p.in[i] = (const float*)d_in[i];
  p.out = (float*)d_out;
  p.ws = (char*)d_ws;
#if N_LAUNCH_MODE == 1
  p.ph_lo = 0; p.ph_hi = NPHASE;
  (void)hipMemsetAsync((char*)d_ws + WS_END, 0, XCD_BAR_WORDS * 4, stream);
  void* args[] = {&p};
  hipError_t e = hipLaunchCooperativeKernel((void*)mega, dim3(grid), dim3(256), args, 0, stream);
  if (e != hipSuccess) fprintf(stderr, "cooperative launch failed: %s (grid %d)\n", hipGetErrorString(e), grid);
#else
  p.ph_lo = 0; p.ph_hi = NPHASE;
  hipLaunchKernelGGL(mega_one<0>, dim3(grid), dim3(256), 0, stream, p);
  hipLaunchKernelGGL(mega_one<1>, dim3(grid), dim3(256), 0, stream, p);
  hipLaunchKernelGGL(mega_one<2>, dim3(grid), dim3(256), 0, stream, p);
  hipLaunchKernelGGL(mega_one<3>, dim3(grid), dim3(256), 0, stream, p);
  hipLaunchKernelGGL(mega_one<4>, dim3(grid), dim3(256), 0, stream, p);
  hipLaunchKernelGGL(mega_one<5>, dim3(grid), dim3(256), 0, stream, p);
  hipLaunchKernelGGL(mega_one<6>, dim3(grid), dim3(256), 0, stream, p);
  hipLaunchKernelGGL(mega_one<7>, dim3(grid), dim3(256), 0, stream, p);
  hipLaunchKernelGGL(mega_one<8>, dim3(grid), dim3(256), 0, stream, p);
  hipLaunchKernelGGL(mega_one<9>, dim3(grid), dim3(256), 0, stream, p);
  hipLaunchKernelGGL(mega_one<10>, dim3(grid), dim3(256), 0, stream, p);
#endif
}
```

```cpp
#include <hip/hip_runtime.h>
#include <hip/hip_cooperative_groups.h>
#include <stdint.h>
#include <stdio.h>
namespace cg = cooperative_groups;

#ifndef N_LAUNCH_MODE
#define N_LAUNCH_MODE 1
#endif

typedef _Float16 h16;
typedef _Float16 h16x8 __attribute__((ext_vector_type(8)));
typedef _Float16 h16x4 __attribute__((ext_vector_type(4)));
typedef float f32x16 __attribute__((ext_vector_type(16)));
typedef float f32x4 __attribute__((ext_vector_type(4)));
typedef float f32x2 __attribute__((ext_vector_type(2)));

#define FI __device__ __forceinline__

constexpr int DM = 1024;
constexpr int MTOK = 17024;
constexpr int TPR = 2064;
constexpr int NPTOK = 16512;
constexpr int RWP = 3360;
constexpr int PTOT = 8480;
constexpr int DFF = 2816;
constexpr int LAW = 320;
constexpr int NMT_H = 136;
constexpr int NMT = 133;

constexpr size_t O_YP = 0, O_YS = 16777216, O_WKV = 17301504, O_SH = 26214400, O_SC = 26671360, O_FFN = 26949888;

constexpr size_t WS_WIN = 0;
constexpr size_t WS_WA = 17563648, WS_WB = 19660800, WS_WO = 21757952;
constexpr size_t WS_WUP = 23855104, WS_WDN = 35389440;
constexpr size_t WS_WLD = 41156608, WS_WLA = 41287680, WS_WLG = 41418752;
constexpr size_t WS_B = 41811968;
constexpr size_t WS_A = 146407424;
constexpr size_t WS_C = 181272576;
constexpr size_t WS_D = 216137728;
constexpr size_t WS_E = 251002880;
constexpr size_t WS_END = 261898240;

struct Params {
  const float* in[30];
  float* out;
  char* ws;
  int ph_lo, ph_hi;
};

enum { I_XP = 0, I_XS, I_SWKV, I_SSH, I_SSC, I_SFFN, I_META, I_N1G, I_WIN, I_BG, I_MU, I_W0, I_WDEC, I_A0, I_WAAA,
       I_WGATE, I_KK, I_KA, I_RK, I_LNG, I_LNB, I_WBR, I_WBS, I_CSC, I_WOUT, I_N2G, I_WUP, I_CFFN, I_WDN, I_FNG };

FI float sigm(float x) { return __builtin_amdgcn_rcpf(1.f + __expf(-x)); }
FI float tanh_(float x) { return 1.f - 2.f * __builtin_amdgcn_rcpf(1.f + __expf(2.f * x)); }
FI float wave_sum(float v) {
#pragma unroll
  for (int o = 32; o; o >>= 1) v += __shfl_xor(v, o);
  return v;
}
FI float sum16(float v) {
#pragma unroll
  for (int o = 8; o; o >>= 1) v += __shfl_xor(v, o);
  return v;
}
FI float quad_sum(float v) {
  float t = __builtin_bit_cast(float, __builtin_amdgcn_update_dpp(0, __builtin_bit_cast(int, v), 0xB1, 0xF, 0xF, true));
  v += t;
  t = __builtin_bit_cast(float, __builtin_amdgcn_update_dpp(0, __builtin_bit_cast(int, v), 0x4E, 0xF, 0xF, true));
  return v + t;
}
struct Tok { int seq, t, T; };
FI Tok tokinfo(int m) {
  Tok k;
  if (m < NPTOK) { k.seq = m / TPR; k.t = m - k.seq * TPR; k.T = TPR; }
  else { int mm = m - NPTOK; k.seq = 8 + (mm >> 2); k.t = mm & 3; k.T = 4; }
  return k;
}
FI const float* xrow(const Params& p, int m) {
  if (m < NPTOK) {
    int s = m / TPR, t = m - s * TPR;
    return t < 16 ? p.in[I_META] + t * DM : p.in[I_XP] + ((size_t)s * 2048 + (t - 16)) * DM;
  }
  return p.in[I_XS] + (size_t)(m - NPTOK) * DM;
}

FI int swz(int row, int chunk) { return row * 128 + ((chunk ^ ((row >> 1) & 7)) << 4); }

FI void zero_acc(f32x4 (&acc)[4][4]) {
#pragma unroll
  for (int a = 0; a < 4; ++a)
#pragma unroll
    for (int b = 0; b < 4; ++b) acc[a][b] = f32x4{0.f, 0.f, 0.f, 0.f};
}

FI void mainloop(f32x4 (&acc)[4][4], const h16* __restrict__ A, int lda, int mbase,
                 const h16* __restrict__ BT, int ldb, int K, char* lds) {
  const int tid = threadIdx.x, lane = tid & 63, wave = tid >> 6, wr = wave >> 1, wc = wave & 1;
  uint32_t aoff[4], boff[4];
#pragma unroll
  for (int i = 0; i < 4; ++i) {
    const int row = wave * 32 + i * 8 + (lane >> 3);
    const int chunk = (lane & 7) ^ ((row >> 1) & 7);
    int m = mbase + row; m = m < 0 ? 0 : (m > MTOK - 1 ? MTOK - 1 : m);
    aoff[i] = (uint32_t)m * lda + chunk * 8;
    boff[i] = (uint32_t)row * ldb + chunk * 8;
  }
  const int ldsw = wave * 4096 + lane * 16;
#define ML_ISSUE(KT, BUF) do { _Pragma("unroll") for (int i = 0; i < 4; ++i) { \
    __builtin_amdgcn_global_load_lds((const unsigned*)(A + aoff[i] + (KT) * 64), (unsigned*)(lds + (BUF) * 32768 + ldsw + i * 1024), 16, 0, 0); \
    __builtin_amdgcn_global_load_lds((const unsigned*)(BT + boff[i] + (KT) * 64), (unsigned*)(lds + (BUF) * 32768 + 16384 + ldsw + i * 1024), 16, 0, 0); } } while (0)
  const int nk = K >> 6;
  const int rA0 = wr * 64 + (lane & 15), rB0 = wc * 64 + (lane & 15), hh = lane >> 4;
  ML_ISSUE(0, 0);
  for (int kt = 0; kt < nk; ++kt) {
    const int buf = kt & 1;
    asm volatile("s_waitcnt vmcnt(0)" ::: "memory");
    __syncthreads();
    if (kt + 1 < nk) ML_ISSUE(kt + 1, buf ^ 1);
    const char* la = lds + buf * 32768;
    const char* lb = la + 16384;
#pragma unroll
    for (int ks = 0; ks < 2; ++ks) {
      h16x8 a[4], b[4];
#pragma unroll
      for (int t = 0; t < 4; ++t) {
        a[t] = *(const h16x8*)(la + swz(rA0 + t * 16, ks * 4 + hh));
        b[t] = *(const h16x8*)(lb + swz(rB0 + t * 16, ks * 4 + hh));
      }
#pragma unroll
      for (int ti = 0; ti < 4; ++ti)
#pragma unroll
        for (int tj = 0; tj < 4; ++tj) acc[ti][tj] = __builtin_amdgcn_mfma_f32_16x16x32_f16(a[ti], b[tj], acc[ti][tj], 0, 0, 0);
    }
  }
  __syncthreads();
#undef ML_ISSUE
}

FI int swz32(int row, int chunk) { return row * 64 + ((chunk ^ ((0 - (row >> 2)) & 3)) << 4); }
FI void mainloop2(f32x4 (&acc)[4][4], f32x4 (&acc2)[4][4], const h16* __restrict__ A, int lda, int mbase,
                  const h16* __restrict__ BT1, const h16* __restrict__ BT2, int ldb, int K, char* lds) {
  const int tid = threadIdx.x, lane = tid & 63, wave = tid >> 6, wr = wave >> 1, wc = wave & 1;
  uint32_t aoff[2], boff[2];
#pragma unroll
  for (int i = 0; i < 2; ++i) {
    const int row = wave * 32 + i * 16 + (lane >> 2);
    const int chunk = (lane & 3) ^ ((0 - (row >> 2)) & 3);
    int m = mbase + row; m = m < 0 ? 0 : (m > MTOK - 1 ? MTOK - 1 : m);
    aoff[i] = (uint32_t)m * lda + chunk * 8;
    boff[i] = (uint32_t)row * ldb + chunk * 8;
  }
  const int ldsw = wave * 2048 + lane * 16;
#define ML2_ISSUE(KT, BUF) do { _Pragma("unroll") for (int i = 0; i < 2; ++i) { \
    __builtin_amdgcn_global_load_lds((const unsigned*)(A + aoff[i] + (KT) * 32), (unsigned*)(lds + (BUF) * 24576 + ldsw + i * 1024), 16, 0, 0); \
    __builtin_amdgcn_global_load_lds((const unsigned*)(BT1 + boff[i] + (KT) * 32), (unsigned*)(lds + (BUF) * 24576 + 8192 + ldsw + i * 1024), 16, 0, 0); \
    __builtin_amdgcn_global_load_lds((const unsigned*)(BT2 + boff[i] + (KT) * 32), (unsigned*)(lds + (BUF) * 24576 + 16384 + ldsw + i * 1024), 16, 0, 0); } } while (0)
  const int nk = K >> 5;
  const int rA0 = wr * 64 + (lane & 15), rB0 = wc * 64 + (lane & 15), hh = lane >> 4;
  ML2_ISSUE(0, 0);
  for (int kt = 0; kt < nk; ++kt) {
    const int buf = kt & 1;
    asm volatile("s_waitcnt vmcnt(0)" ::: "memory");
    __syncthreads();
    if (kt + 1 < nk) ML2_ISSUE(kt + 1, buf ^ 1);
    const char* la = lds + buf * 24576;
    const char* lb = la + 8192;
    const char* lc = la + 16384;
    {
      h16x8 a[4], b[4], c[4];
#pragma unroll
      for (int t = 0; t < 4; ++t) {
        a[t] = *(const h16x8*)(la + swz32(rA0 + t * 16, hh));
        b[t] = *(const h16x8*)(lb + swz32(rB0 + t * 16, hh));
        c[t] = *(const h16x8*)(lc + swz32(rB0 + t * 16, hh));
      }
#pragma unroll
      for (int ti = 0; ti < 4; ++ti)
#pragma unroll
        for (int tj = 0; tj < 4; ++tj) {
          acc[ti][tj] = __builtin_amdgcn_mfma_f32_16x16x32_f16(a[ti], b[tj], acc[ti][tj], 0, 0, 0);
          acc2[ti][tj] = __builtin_amdgcn_mfma_f32_16x16x32_f16(a[ti], c[tj], acc2[ti][tj], 0, 0, 0);
        }
    }
  }
  __syncthreads();
#undef ML2_ISSUE
}

#define CROW(ti, reg) (wr * 64 + (ti) * 16 + 4 * (lane >> 4) + (reg))
#define CCOL(tj) (wc * 64 + (tj) * 16 + (lane & 15))

FI void stage_acc(const f32x4 (&acc)[4][4], float* T) {
  const int tid = threadIdx.x, lane = tid & 63, wave = tid >> 6, wr = wave >> 1, wc = wave & 1;
#pragma unroll
  for (int ti = 0; ti < 4; ++ti)
#pragma unroll
    for (int tj = 0; tj < 4; ++tj)
#pragma unroll
      for (int r = 0; r < 4; ++r) T[CROW(ti, r) * 128 + CCOL(tj)] = acc[ti][tj][r];
}

FI int win_map(int dr) {
  if (dr < 3360) return dr;
  if (dr < 3456) return -1;
  if (dr < 4480) return 3360 + (dr - 3456);
  if (dr < 5504) return 5408 + (dr - 4480);
  if (dr < 6528) return 4384 + (dr - 5504);
  return 6432 + (dr - 6528);
}
FI void transpose_tile(const float* __restrict__ src, int ldsrc, int Ksrc, int Nsrc, int mode, int rt, int ktile,
                       h16* __restrict__ dst, int lddst, float* sm) {
  const int tid = threadIdx.x;
  {
    const int rr = tid & 63, kq = tid >> 6;
    const int dr = rt * 64 + rr;
    int col = mode ? win_map(dr) : (dr < Nsrc ? dr : -1);
#pragma unroll
    for (int i = 0; i < 16; ++i) {
      int kk = kq + 4 * i, k = ktile * 64 + kk;
      float v = (col >= 0 && k < Ksrc) ? src[(size_t)k * ldsrc + col] : 0.f;
      sm[kk * 65 + rr] = v;
    }
  }
  __syncthreads();
  {
    const int dr = tid >> 2, seg = tid & 3;
    h16x8 o0, o1;
#pragma unroll
    for (int j = 0; j < 8; ++j) { o0[j] = (h16)sm[(seg * 16 + j) * 65 + dr]; o1[j] = (h16)sm[(seg * 16 + 8 + j) * 65 + dr]; }
    h16* d = dst + (size_t)(rt * 64 + dr) * lddst + ktile * 64 + seg * 16;
    *(h16x8*)d = o0; *(h16x8*)(d + 8) = o1;
  }
  __syncthreads();
}

FI void rms_rows(const Params& p, int mode, const float* __restrict__ src, const float* __restrict__ g, h16* dsth, int gw, int nw) {
  const int lane = threadIdx.x & 63;
  for (int m = gw; m < MTOK; m += nw) {
    f32x4 v[4]; float ss = 0.f;
    if (mode == 0) {
      const float* row = xrow(p, m);
#pragma unroll
      for (int i = 0; i < 4; ++i) v[i] = *(const f32x4*)(row + lane * 4 + 256 * i);
    } else {
      const h16* row = (const h16*)src + (size_t)m * DM;
#pragma unroll
      for (int i = 0; i < 4; ++i) { const h16x4 h = *(const h16x4*)(row + lane * 4 + 256 * i); v[i] = f32x4{(float)h[0], (float)h[1], (float)h[2], (float)h[3]}; }
    }
#pragma unroll
    for (int i = 0; i < 4; ++i) ss += v[i].x * v[i].x + v[i].y * v[i].y + v[i].z * v[i].z + v[i].w * v[i].w;
    ss = wave_sum(ss);
    const float rs = rsqrtf(ss * (1.f / DM) + 1e-6f);
    if (mode == 2) {
      float* o;
      if (m < NPTOK) { int s = m / TPR, t = m - s * TPR; if (t < 16) continue; o = p.out + O_YP + ((size_t)s * 2048 + (t - 16)) * DM; }
      else o = p.out + O_YS + (size_t)(m - NPTOK) * DM;
#pragma unroll
      for (int i = 0; i < 4; ++i) { f32x4 gg = *(const f32x4*)(g + lane * 4 + 256 * i); f32x4 r = v[i] * rs * gg; *(f32x4*)(o + lane * 4 + 256 * i) = r; }
    } else {
#pragma unroll
      for (int i = 0; i < 4; ++i) {
        f32x4 gg = *(const f32x4*)(g + lane * 4 + 256 * i); f32x4 r = v[i] * rs * gg;
        h16x4 h; h[0] = (h16)r.x; h[1] = (h16)r.y; h[2] = (h16)r.z; h[3] = (h16)r.w;
        *(h16x4*)(dsth + (size_t)m * DM + lane * 4 + 256 * i) = h;
      }
    }
  }
}

FI void transpose_item(const Params& p, float* sm, int it) {
  {
    int i = it;
    if (i < 2144) { transpose_tile(p.in[I_WIN], PTOT, 1024, PTOT, 1, i >> 4, i & 15, (h16*)(p.ws + WS_WIN), 1024, sm); return; }
    i -= 2144;
    if (i < 256) { transpose_tile(p.in[I_WBR], 1024, 1024, 1024, 0, i >> 4, i & 15, (h16*)(p.ws + WS_WA), 1024, sm); return; }
    i -= 256;
    if (i < 256) { transpose_tile(p.in[I_WBS], 1024, 1024, 1024, 0, i >> 4, i & 15, (h16*)(p.ws + WS_WB), 1024, sm); return; }
    i -= 256;
    if (i < 256) { transpose_tile(p.in[I_WOUT], 1024, 1024, 1024, 0, i >> 4, i & 15, (h16*)(p.ws + WS_WO), 1024, sm); return; }
    i -= 256;
    if (i < 1408) { transpose_tile(p.in[I_WUP], 5632, 1024, 5632, 0, i >> 4, i & 15, (h16*)(p.ws + WS_WUP), 1024, sm); return; }
    i -= 1408;
    if (i < 704) { transpose_tile(p.in[I_WDN], 1024, 2816, 1024, 0, i / 44, i % 44, (h16*)(p.ws + WS_WDN), 2816, sm); return; }
    i -= 704;
    if (i < 16) { transpose_tile(p.in[I_WDEC], 1024, 64, 1024, 0, i, 0, (h16*)(p.ws + WS_WLD), 64, sm); return; }
    i -= 16;
    if (i < 16) { transpose_tile(p.in[I_WAAA], 1024, 64, 1024, 0, i, 0, (h16*)(p.ws + WS_WLA), 64, sm); return; }
    i -= 16;
    transpose_tile(p.in[I_WGATE], 1024, 160, 1024, 0, i / 3, i % 3, (h16*)(p.ws + WS_WLG), 192, sm);
  }
}

FI void phase0(const Params& p, char* lds) {
  float* sm = (float*)lds;
  h16* ws = (h16*)p.ws;
  for (int it = blockIdx.x; it < 2144 + 80; it += gridDim.x) transpose_item(p, sm, it < 2144 ? it : it + 2880);
  (void)ws;
  rms_rows(p, 0, nullptr, p.in[I_N1G], (h16*)(p.ws + WS_A), blockIdx.x * 4 + (threadIdx.x >> 6), gridDim.x * 4);
}

struct F8 { f32x4 a, b; };
FI F8 ld16(const h16* q) { h16x8 v = *(const h16x8*)q; F8 r; r.a = f32x4{(float)v[0], (float)v[1], (float)v[2], (float)v[3]}; r.b = f32x4{(float)v[4], (float)v[5], (float)v[6], (float)v[7]}; return r; }
FI F8 ld32(const float* q) { F8 r; r.a = *(const f32x4*)q; r.b = *(const f32x4*)(q + 4); return r; }
FI F8 zero8() { F8 r; r.a = f32x4{0.f, 0.f, 0.f, 0.f}; r.b = r.a; return r; }
FI void st16(h16* q, const F8& v) { h16x8 h; h[0] = (h16)v.a.x; h[1] = (h16)v.a.y; h[2] = (h16)v.a.z; h[3] = (h16)v.a.w; h[4] = (h16)v.b.x; h[5] = (h16)v.b.y; h[6] = (h16)v.b.z; h[7] = (h16)v.b.w; *(h16x8*)q = h; }
FI void st32(float* q, const F8& v) { *(f32x4*)q = v.a; *(f32x4*)(q + 4) = v.b; }
FI void stage16(const f32x4 (&acc)[4][4], h16* T) {
  const int tid = threadIdx.x, lane = tid & 63, wave = tid >> 6, wr = wave >> 1, wc = wave & 1;
#pragma unroll
  for (int ti = 0; ti < 4; ++ti)
#pragma unroll
    for (int tj = 0; tj < 4; ++tj)
#pragma unroll
      for (int r = 0; r < 4; ++r) T[CROW(ti, r) * 128 + CCOL(tj)] = (h16)acc[ti][tj][r];
}
typedef _Float16 h16x2 __attribute__((ext_vector_type(2)));
FI void pack_acc(const f32x4 (&acc)[4][4], uint32_t (&pk)[4][4][2]) {
#pragma unroll
  for (int ti = 0; ti < 4; ++ti)
#pragma unroll
    for (int tj = 0; tj < 4; ++tj)
#pragma unroll
      for (int r = 0; r < 4; r += 2) {
        h16x2 h2; h2[0] = (h16)acc[ti][tj][r]; h2[1] = (h16)acc[ti][tj][r + 1];
        pk[ti][tj][r >> 1] = __builtin_bit_cast(uint32_t, h2);
      }
}
FI void stage16_pk(const uint32_t (&pk)[4][4][2], h16* T) {
  const int tid = threadIdx.x, lane = tid & 63, wave = tid >> 6, wr = wave >> 1, wc = wave & 1;
#pragma unroll
  for (int ti = 0; ti < 4; ++ti)
#pragma unroll
    for (int tj = 0; tj < 4; ++tj)
#pragma unroll
      for (int r = 0; r < 4; r += 2) {
        h16x2 h2 = __builtin_bit_cast(h16x2, pk[ti][tj][r >> 1]);
        T[CROW(ti, r) * 128 + CCOL(tj)] = h2[0];
        T[CROW(ti, r + 1) * 128 + CCOL(tj)] = h2[1];
      }
}
FI void conv_prev(const h16* T, int row, int c8, const Tok& k, const float* st  , int ld, F8& p1, F8& p2) {
  if (k.t >= 2) { p1 = ld16(T + (row - 1) * 128 + c8); p2 = ld16(T + (row - 2) * 128 + c8); }
  else if (k.t == 1) { p1 = ld16(T + (row - 1) * 128 + c8); p2 = k.seq >= 8 ? ld32(st + ld) : zero8(); }
  else { if (k.seq >= 8) { p1 = ld32(st + ld); p2 = ld32(st); } else { p1 = zero8(); p2 = zero8(); } }
}

FI h16x8 cvth(const F8& v) { h16x8 h; h[0] = (h16)v.a.x; h[1] = (h16)v.a.y; h[2] = (h16)v.a.z; h[3] = (h16)v.a.w; h[4] = (h16)v.b.x; h[5] = (h16)v.b.y; h[6] = (h16)v.b.z; h[7] = (h16)v.b.w; return h; }
FI F8 cvtf(const h16x8& v) { F8 r; r.a = f32x4{(float)v[0], (float)v[1], (float)v[2], (float)v[3]}; r.b = f32x4{(float)v[4], (float)v[5], (float)v[6], (float)v[7]}; return r; }
FI h16x8 zeroh() { h16x8 h; for (int i = 0; i < 8; ++i) h[i] = (h16)0.f; return h; }
FI void conv_prev16(const h16* T, int row, int c8, const Tok& k, const float* st  , int ld, h16x8& p1, h16x8& p2) {
  if (k.t >= 2) { p1 = *(const h16x8*)(T + (row - 1) * 128 + c8); p2 = *(const h16x8*)(T + (row - 2) * 128 + c8); }
  else if (k.t == 1) { p1 = *(const h16x8*)(T + (row - 1) * 128 + c8); p2 = k.seq >= 8 ? cvth(ld32(st + ld)) : zeroh(); }
  else { if (k.seq >= 8) { p1 = cvth(ld32(st + ld)); p2 = cvth(ld32(st)); } else { p1 = zeroh(); p2 = zeroh(); } }
}

FI void phase1(const Params& p, char* lds) {
  const int tid = threadIdx.x;
  const h16* XN = (const h16*)(p.ws + WS_A);
  const h16* WinT = (const h16*)(p.ws + WS_WIN);
  h16* PB = (h16*)(p.ws + WS_B);
  h16* ZB = (h16*)(p.ws + WS_C);
  h16* LA = (h16*)(p.ws + WS_E);
  const int c8 = (tid & 15) * 8, r0 = tid >> 4;
  for (int it = blockIdx.x; it < 35 * NMT_H; it += gridDim.x) {
    const int j = it / NMT_H, mt = it - j * NMT_H;
    const int mbase = mt * 126 - 2;
    {
      const int npass = j < 8 ? 3 : 1;
      uint32_t pk[4][4][2];
#pragma unroll 1
      for (int pass = 0; pass < npass; ++pass) {
        int brow;
        if (j < 8) brow = (pass == 0 ? 3456 : (pass == 1 ? 4480 : 5504)) + j * 128;
        else brow = (j - 8) * 128;
        f32x4 acc[4][4];
        zero_acc(acc);
        mainloop(acc, XN, DM, mbase, WinT + (size_t)brow * DM, DM, DM, lds);
        if (j < 8) {
          if (pass == 0) pack_acc(acc, pk);
          else if (pass == 1) {
#pragma unroll
            for (int ti = 0; ti < 4; ++ti)
#pragma unroll
              for (int tj = 0; tj < 4; ++tj)
#pragma unroll
                for (int r = 0; r < 4; r += 2) {
                  h16x2 h2 = __builtin_bit_cast(h16x2, pk[ti][tj][r >> 1]);
                  h2[0] = (h16)((float)h2[0] * acc[ti][tj][r]); h2[1] = (h16)((float)h2[1] * acc[ti][tj][r + 1]);
                  pk[ti][tj][r >> 1] = __builtin_bit_cast(uint32_t, h2);
                }
          } else { stage16_pk(pk, (h16*)lds); stage16(acc, (h16*)lds + 16384); }
        } else stage_acc(acc, (float*)lds);
      }
    }
    if (j < 8) {
      const int n0 = j * 128;
      h16* TU = (h16*)lds; h16* TB = TU + 16384;
      __syncthreads();
      const int ch = n0 + c8;
      const float* cw = p.in[I_CSC];
      const h16x8 w0 = cvth(ld32(cw + ch)), w1 = cvth(ld32(cw + 1024 + ch)), w2 = cvth(ld32(cw + 2048 + ch));
#pragma unroll 1
      for (int i = 0; i < 8; ++i) {
        const int row = r0 + 16 * i, m = mbase + row;
        if (row < 2 || m >= MTOK) continue;
        const Tok k = tokinfo(m);
        const h16x8 cur = *(const h16x8*)(TU + row * 128 + c8), bg = *(const h16x8*)(TB + row * 128 + c8);
        h16x8 p1, p2;
        conv_prev16(TU, row, c8, k, p.in[I_SSC] + (size_t)(k.seq - 8) * 2048 + ch, 1024, p1, p2);
        *(h16x8*)(ZB + (size_t)m * DM + ch) = bg * (w0 * p2 + w1 * p1 + w2 * cur);
        if (k.t >= k.T - 2) st32(p.out + O_SC + (size_t)k.seq * 2048 + (k.t - (k.T - 2)) * 1024 + ch, cvtf(cur));
      }
      __syncthreads();
    } else {
      const int n0 = (j - 8) * 128;
      float* T = (float*)lds;
      __syncthreads();
      const int n = n0 + c8;
      const F8 muv = n < RWP ? ld32(p.in[I_MU] + n) : zero8();
#pragma unroll 1
      for (int i = 0; i < 8; ++i) {
        const int row = r0 + 16 * i, m = mbase + row;
        if (row < 2 || m >= MTOK) continue;
        const Tok k = tokinfo(m);
        const F8 cur = ld32(T + row * 128 + c8);
        F8 prev;
        if (k.t >= 1) prev = ld32(T + (row - 1) * 128 + c8);
        else prev = (k.seq >= 8 && n < RWP) ? ld32(p.in[I_SSH] + (size_t)(k.seq - 8) * RWP + n) : zero8();
        F8 xs;
        xs.a = cur.a + (prev.a - cur.a) * muv.a;
        xs.b = cur.b + (prev.b - cur.b) * muv.b;
        if (n < 3072) st16(PB + (size_t)m * 3072 + n, xs);
        else {
          const int q = n - 3072;
          if (q < LAW) {
            F8 v;
            if (q < 64) { v.a = f32x4{tanh_(xs.a.x), tanh_(xs.a.y), tanh_(xs.a.z), tanh_(xs.a.w)}; v.b = f32x4{tanh_(xs.b.x), tanh_(xs.b.y), tanh_(xs.b.z), tanh_(xs.b.w)}; }
            else if (q < 128) v = xs;
            else if (q < 288) { v.a = f32x4{sigm(xs.a.x), sigm(xs.a.y), sigm(xs.a.z), sigm(xs.a.w)}; v.b = f32x4{sigm(xs.b.x), sigm(xs.b.y), sigm(xs.b.z), sigm(xs.b.w)}; }
            else v = zero8();
            st16(LA + (size_t)m * LAW + q, v);
          }
        }
        if (n < RWP && k.t == k.T - 1) st32(p.out + O_SH + (size_t)k.seq * RWP + n, cur);
      }
      __syncthreads();
    }
  }
}

template <int CTRL> FI float dpp_mov(float v) { return __builtin_bit_cast(float, __builtin_amdgcn_update_dpp(0, __builtin_bit_cast(int, v), CTRL, 0xF, 0xF, true)); }
FI float row8_sum(float v) { v += dpp_mov<0xB1>(v); v += dpp_mov<0x4E>(v); v += dpp_mov<0x141>(v); return v; }
FI float row16_sum(float v) { v = row8_sum(v); v += dpp_mov<0x140>(v); return v; }

constexpr size_t OUT_Y_BYTES = 34865152;
constexpr size_t WS_YS = WS_END + 65536;
constexpr size_t WS_RK = WS_YS + 1048576;
FI h16* yrow(const Params& p, int m) {
  return m < NPTOK ? (h16*)((char*)p.out + OUT_Y_BYTES) + (size_t)m * DM : (h16*)(p.ws + WS_YS) + (size_t)(m - NPTOK) * DM;
}

FI void phaseA(const Params& p, char* lds) {
  const int tid = threadIdx.x, lane = tid & 63, wave = tid >> 6, wr = wave >> 1, wc = wave & 1;
  const h16* LA = (const h16*)(p.ws + WS_E);
  h16* DA = (h16*)p.out;
  h16* AA = (h16*)(p.ws + WS_D);
  for (int it = blockIdx.x; it < 16 * NMT; it += gridDim.x) {
    const int j = it / NMT, mt = it - j * NMT;
    const int mbase = mt * 128, which = j >> 3, n0 = (j & 7) * 128;
    f32x4 acc[4][4];
    zero_acc(acc);
    if (which == 0) mainloop(acc, LA, LAW, mbase, (const h16*)(p.ws + WS_WLD) + (size_t)n0 * 64, 64, 64, lds);
    else mainloop(acc, LA + 64, LAW, mbase, (const h16*)(p.ws + WS_WLA) + (size_t)n0 * 64, 64, 64, lds);
    h16* dst = which == 0 ? DA : AA;
    stage_acc(acc, (float*)lds);
    __syncthreads();
    if (which == 0) {
      const float* T = (const float*)lds;
      const int ci = tid >> 5, cq = (tid & 31) * 4, n = n0 + cq;
      const f32x4 bias = *(const f32x4*)(p.in[I_W0] + n);
      f32x4 run = {1.f, 1.f, 1.f, 1.f};
#pragma unroll 1
      for (int rr = 0; rr < 16; ++rr) {
        const int row = ci * 16 + rr, m = mbase + row;
        if (m >= NPTOK && (m & 3) == 0) run = f32x4{1.f, 1.f, 1.f, 1.f};
        const f32x4 x = *(const f32x4*)(T + row * 128 + cq) + bias;
        run = run * f32x4{__expf(-0.60653066f * sigm(x.x)), __expf(-0.60653066f * sigm(x.y)), __expf(-0.60653066f * sigm(x.z)), __expf(-0.60653066f * sigm(x.w))};
        h16x4 h; h[0] = (h16)run.x; h[1] = (h16)run.y; h[2] = (h16)run.z; h[3] = (h16)run.w;
        *(h16x4*)(dst + (size_t)m * DM + n) = h;
      }
    } else {
      const float* T = (const float*)lds;
      const int c8 = (tid & 15) * 8, r0 = tid >> 4, n = n0 + c8;
      const float* w0p = p.in[I_W0]; const float* a0p = p.in[I_A0];
      const F8 bias = ld32((which == 0 ? w0p : a0p) + n);
#pragma unroll 1
      for (int i = 0; i < 8; ++i) {
        const int row = r0 + 16 * i, m = mbase + row;
        const F8 a = ld32(T + row * 128 + c8);
        const f32x4 xa = a.a + bias.a, xb = a.b + bias.b;
        F8 o;
        o.a = f32x4{sigm(xa.x), sigm(xa.y), sigm(xa.z), sigm(xa.w)}; o.b = f32x4{sigm(xb.x), sigm(xb.y), sigm(xb.z), sigm(xb.w)};
        if (which == 0) {
          o.a = f32x4{__expf(-0.60653066f * o.a.x), __expf(-0.60653066f * o.a.y), __expf(-0.60653066f * o.a.z), __expf(-0.60653066f * o.a.w)};
          o.b = f32x4{__expf(-0.60653066f * o.b.x), __expf(-0.60653066f * o.b.y), __expf(-0.60653066f * o.b.z), __expf(-0.60653066f * o.b.w)};
        }
        st16(dst + (size_t)m * DM + n, o);
      }
    }
    __syncthreads();
  }
}

FI void scan_unit(const Params& p, float* sm, int seq, int head, int half) {
  const int tid = threadIdx.x;
  const int T = seq < 8 ? TPR : 4;
  const int mseq = seq < 8 ? seq * TPR : NPTOK + (seq - 8) * 4;
  const h16* PB = (const h16*)(p.ws + WS_B);
  const h16* DA = (const h16*)p.out;
  const h16* AA = (const h16*)(p.ws + WS_D);
  const int rp = tid >> 4, cb = tid & 15;
  const int chp = head * 64 + cb * 4;
  const int row0 = half * 32 + rp * 2;
  f32x2 S0a, S0b, S1a, S1b;
  if (seq >= 8) {
    const float* sp = p.in[I_SWKV] + ((size_t)(seq - 8) * 16 + head) * 4096 + row0 * 64 + cb * 4;
    const f32x4 u = *(const f32x4*)sp, w = *(const f32x4*)(sp + 64);
    S0a = f32x2{u.x, u.y}; S0b = f32x2{u.z, u.w}; S1a = f32x2{w.x, w.y}; S1b = f32x2{w.z, w.w};
  } else { S0a = f32x2{0.f, 0.f}; S0b = S0a; S1a = S0a; S1b = S0a; }
  const f32x4 kkc = *(const f32x4*)(p.in[I_KK] + chp), kac = *(const f32x4*)(p.in[I_KA] + chp), rkc = *(const f32x4*)(p.in[I_RK] + chp);
  float* RKo = (float*)(p.ws + WS_RK);
  const int nch = (T + 15) >> 4;
  h16x2* YPbase = (h16x2*)(sm + 11264);
  h16x4 Apr, Apk, Apv, Apd, Apa, Ape, Bpr, Bpk, Bpv, Bpd, Bpa, Bpe, Cpr, Cpk, Cpv, Cpd, Cpa, Cpe;
#define SC_LOAD(P, T0) do { int mp = (T0) + rp; if (mp > T - 1) mp = T - 1; const size_t mm = (size_t)(mseq + mp); \
    const h16* pp = PB + mm * 3072 + chp; P##pr = *(const h16x4*)pp; P##pk = *(const h16x4*)(pp + 1024); P##pv = *(const h16x4*)(pp + 2048); \
    P##pd = *(const h16x4*)(DA + mm * DM + chp); P##pa = *(const h16x4*)(AA + mm * DM + chp); \
    P##pe = *(const h16x4*)(DA + (mm - (rp > 0 ? 1 : 0)) * DM + chp); } while (0)
#define SC_PREP(P, BUF, T0) do { float* bb = sm + (BUF) * 5632; \
    const f32x4 r4 = {(float)P##pr[0], (float)P##pr[1], (float)P##pr[2], (float)P##pr[3]}; \
    const f32x4 k4 = {(float)P##pk[0], (float)P##pk[1], (float)P##pk[2], (float)P##pk[3]}; \
    const f32x4 v4 = {(float)P##pv[0], (float)P##pv[1], (float)P##pv[2], (float)P##pv[3]}; \
    const f32x4 lam = {(float)P##pd[0], (float)P##pd[1], (float)P##pd[2], (float)P##pd[3]}; \
    f32x4 lam1 = {(float)P##pe[0], (float)P##pe[1], (float)P##pe[2], (float)P##pe[3]}; \
    if (rp == 0) lam1 = f32x4{1.f, 1.f, 1.f, 1.f}; \
    const f32x4 linv = f32x4{__builtin_amdgcn_rcpf(lam.x), __builtin_amdgcn_rcpf(lam.y), __builtin_amdgcn_rcpf(lam.z), __builtin_amdgcn_rcpf(lam.w)}; \
    const f32x4 a4 = {(float)P##pa[0], (float)P##pa[1], (float)P##pa[2], (float)P##pa[3]}; \
    const f32x4 kkv = k4 * kkc; \
    const float ss = row16_sum(kkv.x * kkv.x + kkv.y * kkv.y + kkv.z * kkv.z + kkv.w * kkv.w); \
    const f32x4 kk = kkv * __builtin_amdgcn_rcpf(fmaxf(__builtin_amdgcn_sqrtf(ss), 1e-12f)); \
    const int o = rp * 64 + cb * 4; \
      \
    const f32x4 kp_ = k4 * (1.f + (a4 - 1.f) * kac); \
    { const f32x4 rk4_ = r4 * kp_ * rkc; const float rks_ = row16_sum((rk4_.x + rk4_.y) + (rk4_.z + rk4_.w)); \
      if (half == 0 && cb == 0 && (T0) + rp < T) RKo[(size_t)(mseq + (T0) + rp) * 16 + head] = rks_; } \
    *(f32x4*)(bb + o) = r4 * lam; *(f32x4*)(bb + 1024 + o) = lam; *(f32x4*)(bb + 2048 + o) = kp_ * linv; \
    if ((cb >> 3) == half) *(f32x4*)(bb + 5120 + rp * 32 + (cb & 7) * 4) = v4;     \
    *(f32x4*)(bb + 3072 + o) = -kk * lam1; *(f32x4*)(bb + 4096 + o) = kk * a4 * linv; } while (0)
#define ST_LOAD(X, TT) do { const float* q_ = bb + (TT) * 64 + cb * 4; \
    X##a = *(const f32x4*)(q_ + 3072); X##b = *(const f32x4*)(q_ + 4096); \
    X##k = *(const f32x4*)(q_ + 2048); X##r = *(const f32x4*)q_; X##v = *(const f32x2*)(bb + 5120 + (TT) * 32 + rp * 2); } while (0)
#define LO(v) f32x2{(v).x, (v).y}
#define HI(v) f32x2{(v).z, (v).w}
#define ST_COMP(X, TT) do { \
    f32x2 s0_ = S0a * LO(X##a), s1_ = S1a * LO(X##a); s0_ = S0b * HI(X##a) + s0_; s1_ = S1b * HI(X##a) + s1_; \
    const f32x2 v0_ = {X##v.x, X##v.x}, v1_ = {X##v.y, X##v.y}; \
    const f32x2 u0a_ = LO(X##k) * v0_ + S0a, u0b_ = HI(X##k) * v0_ + S0b; \
    const f32x2 u1a_ = LO(X##k) * v1_ + S1a, u1b_ = HI(X##k) * v1_ + S1b; \
    const float sa0_ = row16_sum(s0_.x + s0_.y), sa1_ = row16_sum(s1_.x + s1_.y); \
    const f32x2 q0_ = {sa0_, sa0_}, q1_ = {sa1_, sa1_}; \
    S0a = LO(X##b) * q0_ + u0a_; S0b = HI(X##b) * q0_ + u0b_; S1a = LO(X##b) * q1_ + u1a_; S1b = HI(X##b) * q1_ + u1b_; \
    f32x2 y0_ = S0a * LO(X##r), y1_ = S1a * LO(X##r); y0_ = S0b * HI(X##r) + y0_; y1_ = S1b * HI(X##r) + y1_; \
    { h16x2 yp_; yp_[0] = (h16)(y0_.x + y0_.y); yp_[1] = (h16)(y1_.x + y1_.y); YP[(TT) * 256 + tid] = yp_; } } while (0)
#define SC_BODY(c, LSET, PSET) do { \
    const int t0 = (c) * 16; \
    const int nt = (T - t0) < 16 ? (T - t0) : 16;       \
    const float* bb = sm + ((c) & 1) * 5632; \
    h16x2* YP = YPbase + ((c) & 1) * 4096; \
    if ((c) + 3 < nch) SC_LOAD(LSET, t0 + 48); \
    if ((c) > 0) SC_YRED((c) - 1, 16); \
    { \
      f32x4 Aa, Ab, Ak, Ar; f32x2 Av; \
      f32x4 Ba, Bb, Bk, Br; f32x2 Bv; \
      ST_LOAD(A, 0); \
      for (int tt = 0; tt < nt; tt += 2) { \
        ST_LOAD(B, tt + 1); \
        ST_COMP(A, tt); \
        const int tn = tt + 2 < nt ? tt + 2 : tt; \
        ST_LOAD(A, tn); \
        ST_COMP(B, tt + 1); \
      } \
    } \
    {   \
      const f32x4 ll_ = *(const f32x4*)(bb + 1024 + (nt - 1) * 64 + cb * 4); \
      S0a = S0a * LO(ll_); S0b = S0b * HI(ll_); S1a = S1a * LO(ll_); S1b = S1b * HI(ll_); } \
    if ((c) + 1 < nch) SC_PREP(PSET, ((c) + 1) & 1, t0 + 16);     \
    __syncthreads(); } while (0)
#define SC_YRED(CC, NT) do { if (rp < (NT)) { \
      const uint4* q_ = (const uint4*)(YPbase + ((CC) & 1) * 4096 + rp * 256 + cb * 16); \
      float a0_ = 0.f, a1_ = 0.f; \
      _Pragma("unroll") for (int e_ = 0; e_ < 4; ++e_) { \
        const uint4 w_ = q_[e_]; \
        const h16x2 p0_ = __builtin_bit_cast(h16x2, w_.x), p1_ = __builtin_bit_cast(h16x2, w_.y), p2_ = __builtin_bit_cast(h16x2, w_.z), p3_ = __builtin_bit_cast(h16x2, w_.w); \
        a0_ += ((float)p0_[0] + (float)p1_[0]) + ((float)p2_[0] + (float)p3_[0]); \
        a1_ += ((float)p0_[1] + (float)p1_[1]) + ((float)p2_[1] + (float)p3_[1]); \
      } \
      h16x2 yh; yh[0] = (h16)a0_; yh[1] = (h16)a1_; \
      *(h16x2*)(yrow(p, mseq + (CC) * 16 + rp) + head * 64 + half * 32 + cb * 2) = yh; } } while (0)
  SC_LOAD(A, 0);
  if (nch > 1) { SC_LOAD(B, 16); SC_LOAD(C, 32); }
  SC_PREP(A, 0, 0);
  __syncthreads();
  for (int c = 0; c < nch; c += 3) {
    SC_BODY(c, A, B);
    if (c + 1 < nch) SC_BODY(c + 1, B, C);
    if (c + 2 < nch) SC_BODY(c + 2, C, A);
  }
#undef SC_BODY
  SC_YRED(nch - 1, T - (nch - 1) * 16);
#undef SC_YRED
  {
    float* op = p.out + O_WKV + ((size_t)seq * 16 + head) * 4096 + row0 * 64 + cb * 4;
    *(f32x4*)op = f32x4{S0a.x, S0a.y, S0b.x, S0b.y}; *(f32x4*)(op + 64) = f32x4{S1a.x, S1a.y, S1b.x, S1b.y};
  }
  __syncthreads();
#undef SC_LOAD
#undef SC_PREP
#undef ST_LOAD
#undef ST_COMP
#undef LO
#undef HI
}

FI void phase3(const Params& p, char* lds) {
  float* sm = (float*)lds;
  const int G = gridDim.x, b = blockIdx.x;
  for (int u = b; u < 256; u += G) scan_unit(p, sm, u >> 5, (u >> 1) & 15, u & 1);
  if (G > 256) {
    if (b >= 256) {
      for (int u = b - 256; u < 4096; u += G - 256) scan_unit(p, sm, 8 + (u >> 5), (u >> 1) & 15, u & 1);
      for (int it = 2144 + (b - 256); it < 5024; it += G - 256) transpose_item(p, sm, it);
    }
  }
  else {
    for (int u = b; u < 4096; u += G) scan_unit(p, sm, 8 + (u >> 5), (u >> 1) & 15, u & 1);
    for (int it = 2144 + b; it < 5024; it += G) transpose_item(p, sm, it);
  }
}

FI void phase3b(const Params& p, char* lds) {
  const int tid = threadIdx.x;
  const h16* LA = (const h16*)(p.ws + WS_E);
  const h16* PB = (const h16*)(p.ws + WS_B);
  h16* AZ = (h16*)(p.ws + WS_D);
  const float* RK = (const float*)(p.ws + WS_RK);
  h16* TG = (h16*)lds;
  const int c8 = (tid & 15) * 8, r0 = tid >> 4;
  for (int it = blockIdx.x; it < 8 * NMT; it += gridDim.x) {
    const int j = it / NMT, mt = it - j * NMT;
    const int mbase = mt * 128, n0 = j * 128;
    {
      f32x4 acc[4][4];
      zero_acc(acc);
      mainloop(acc, LA + 128, LAW, mbase, (const h16*)(p.ws + WS_WLG) + (size_t)n0 * 192, 192, 192, lds);
      stage16(acc, TG);
    }
    __syncthreads();
    const int ch = n0 + c8;
    const F8 lg = ld32(p.in[I_LNG] + ch), lb = ld32(p.in[I_LNB] + ch);
#pragma unroll 1
    for (int i = 0; i < 8; ++i) {
      const int row = r0 + 16 * i, m = mbase + row;
      const F8 y = ld16(yrow(p, m) + ch);
      const F8 v = ld16(PB + (size_t)m * 3072 + 2048 + ch);
      const F8 g = ld16(TG + row * 128 + c8);
      const float rk = RK[(size_t)m * 16 + (ch >> 6)];
      const f32x4 ys = y.a + y.b;
      const float mean = row8_sum((ys.x + ys.y) + (ys.z + ys.w)) * (1.f / 64.f);
      F8 d; d.a = y.a - mean; d.b = y.b - mean;
      const f32x4 d2 = d.a * d.a + d.b * d.b;
      const float var = row8_sum((d2.x + d2.y) + (d2.z + d2.w)) * (1.f / 64.f);
      const float rs = rsqrtf(var + 64e-5f);
      F8 z;
      z.a = (d.a * rs * lg.a + lb.a + v.a * rk) * g.a;
      z.b = (d.b * rs * lg.b + lb.b + v.b * rk) * g.b;
      st16(AZ + (size_t)m * DM + ch, z);
    }
    __syncthreads();
  }
}

FI void phase4(const Params& p, char* lds) {
  const int tid = threadIdx.x;
  const h16* XN = (const h16*)(p.ws + WS_A);
  const h16* ZA = (const h16*)(p.ws + WS_D);
  const h16* ZB = (const h16*)(p.ws + WS_C);
  const h16* WinT = (const h16*)(p.ws + WS_WIN);
  const h16* WA = (const h16*)(p.ws + WS_WA);
  const h16* WB = (const h16*)(p.ws + WS_WB);
  h16* MG = (h16*)(p.ws + WS_B);
  h16* G2 = (h16*)(p.ws + WS_B + OUT_Y_BYTES);
  h16* T0 = (h16*)lds; h16* T1 = T0 + 16384;
  const int c8 = (tid & 15) * 8, r0 = tid >> 4;
  for (int it = blockIdx.x; it < 8 * NMT; it += gridDim.x) {
    const int j = it / NMT, mt = it - j * NMT;
    const int mbase = mt * 128, n0 = j * 128, n = n0 + c8;
    {
      f32x4 acc[4][4], acc2[4][4];
      zero_acc(acc); zero_acc(acc2);
      mainloop2(acc, acc2, XN, DM, mbase, WinT + (size_t)(6528 + n0) * DM, WinT + (size_t)(7552 + n0) * DM, DM, DM, lds);
      stage16(acc, T0); stage16(acc2, T1);
    }
    __syncthreads();
    {
      const F8 ba = ld32(p.in[I_BG] + n), bb = ld32(p.in[I_BG] + 1024 + n);
#pragma unroll 1
      for (int i = 0; i < 8; ++i) {
        const int row = r0 + 16 * i; const size_t o = (size_t)(mbase + row) * DM + n;
        const F8 a = ld16(T0 + row * 128 + c8), b = ld16(T1 + row * 128 + c8);
        const f32x4 xa = a.a + ba.a, xb = a.b + ba.b, ya = b.a + bb.a, yb = b.b + bb.b;
        F8 ga, gb;
        ga.a = f32x4{sigm(xa.x), sigm(xa.y), sigm(xa.z), sigm(xa.w)}; ga.b = f32x4{sigm(xb.x), sigm(xb.y), sigm(xb.z), sigm(xb.w)};
        gb.a = f32x4{sigm(ya.x), sigm(ya.y), sigm(ya.z), sigm(ya.w)}; gb.b = f32x4{sigm(yb.x), sigm(yb.y), sigm(yb.z), sigm(yb.w)};
        st16(MG + o, ga); st16(G2 + o, gb);
      }
    }
    __syncthreads();
  }
  for (int it = blockIdx.x; it < 8 * NMT; it += gridDim.x) {
    const int j = it / NMT, mt = it - j * NMT;
    const int mbase = mt * 128, n0 = j * 128, n = n0 + c8;
    {
      uint32_t pk[4][4][2];
#pragma unroll 1
      for (int pass = 0; pass < 2; ++pass) {
        f32x4 acc[4][4];
        zero_acc(acc);
        mainloop(acc, pass == 0 ? ZA : ZB, DM, mbase, (pass == 0 ? WA : WB) + (size_t)n0 * DM, DM, DM, lds);
        if (pass == 0) pack_acc(acc, pk);
        else { stage16_pk(pk, T0); stage16(acc, T1); }
      }
    }
    __syncthreads();
#pragma unroll 1
    for (int i = 0; i < 8; ++i) {
      const int row = r0 + 16 * i; const size_t o = (size_t)(mbase + row) * DM + n;
      const h16x8 oa = *(const h16x8*)(T0 + row * 128 + c8), ob = *(const h16x8*)(T1 + row * 128 + c8);
      const h16x8 ga = *(const h16x8*)(MG + o), gb = *(const h16x8*)(G2 + o);
      *(h16x8*)(MG + o) = ga * oa + gb * ob;
    }
    __syncthreads();
  }
}

FI void phase5_epi(const Params& p, h16* X1, const h16* T, int mbase, int n0) {
  const int tid = threadIdx.x, c8 = (tid & 15) * 8, r0 = tid >> 4, n = n0 + c8;
#pragma unroll 1
  for (int i = 0; i < 8; ++i) {
    const int row = r0 + 16 * i, m = mbase + row;
    const F8 a = ld16(T + row * 128 + c8), x = ld32(xrow(p, m) + n);
    F8 o; o.a = x.a + a.a; o.b = x.b + a.b;
    st16(X1 + (size_t)m * DM + n, o);
  }
}
FI void phase5(const Params& p, char* lds) {
  const h16* MG = (const h16*)(p.ws + WS_B);
  const h16* WO = (const h16*)(p.ws + WS_WO);
  h16* X1 = (h16*)(p.ws + WS_A);
  h16* T0 = (h16*)lds; h16* T1 = T0 + 16384;
  const int G = gridDim.x, NP = 4 * NMT;
  const int nfull = (NP / G) * G;
  for (int it = blockIdx.x; it < nfull; it += G) {
    const int jp = it / NMT, mt = it - jp * NMT;
    const int mbase = mt * 128, n0 = jp * 256;
    {
      f32x4 acc[4][4], acc2[4][4];
      zero_acc(acc); zero_acc(acc2);
      mainloop2(acc, acc2, MG, DM, mbase, WO + (size_t)n0 * DM, WO + (size_t)(n0 + 128) * DM, DM, DM, lds);
      stage16(acc, T0); stage16(acc2, T1);
    }
    __syncthreads();
    phase5_epi(p, X1, T0, mbase, n0);
    phase5_epi(p, X1, T1, mbase, n0 + 128);
    __syncthreads();
  }
  const int nrest = (NP - nfull) * 2;
  for (int w = blockIdx.x; w < nrest; w += G) {
    const int it = nfull + (w >> 1);
    const int jp = it / NMT, mt = it - jp * NMT;
    const int mbase = mt * 128, n0 = jp * 256 + (w & 1) * 128;
    {
      f32x4 acc[4][4];
      zero_acc(acc);
      mainloop(acc, MG, DM, mbase, WO + (size_t)n0 * DM, DM, DM, lds);
      stage16(acc, T0);
    }
    __syncthreads();
    phase5_epi(p, X1, T0, mbase, n0);
    __syncthreads();
  }
}

FI void phase7(const Params& p, char* lds) {
  const int tid = threadIdx.x;
  const h16* XN2 = (const h16*)(p.ws + WS_D);
  const h16* WUP = (const h16*)(p.ws + WS_WUP);
  h16* HH = (h16*)(p.ws + WS_B);
  h16* TG = (h16*)lds; h16* TV = TG + 16384;
  const int c8 = (tid & 15) * 8, r0 = tid >> 4;
  for (int it = blockIdx.x; it < 22 * NMT_H; it += gridDim.x) {
    const int j = it / NMT_H, mt = it - j * NMT_H;
    const int mbase = mt * 126 - 2, n0 = j * 128;
    {
      f32x4 acc[4][4], acc2[4][4];
      zero_acc(acc); zero_acc(acc2);
      mainloop2(acc, acc2, XN2, DM, mbase, WUP + (size_t)n0 * DM, WUP + (size_t)(DFF + n0) * DM, DM, DM, lds);
      stage16(acc, TG); stage16(acc2, TV);
    }
    __syncthreads();
    const int cgc = n0 + c8, cvc = DFF + n0 + c8;
    const float* cw = p.in[I_CFFN];
    const h16x8 g0 = cvth(ld32(cw + cgc)), g1 = cvth(ld32(cw + 5632 + cgc)), g2 = cvth(ld32(cw + 11264 + cgc));
    const h16x8 v0 = cvth(ld32(cw + cvc)), v1 = cvth(ld32(cw + 5632 + cvc)), v2 = cvth(ld32(cw + 11264 + cvc));
#pragma unroll 1
    for (int i = 0; i < 8; ++i) {
      const int row = r0 + 16 * i, m = mbase + row;
      if (row < 2 || m >= MTOK) continue;
      const Tok k = tokinfo(m);
      const h16x8 gc = *(const h16x8*)(TG + row * 128 + c8), vc = *(const h16x8*)(TV + row * 128 + c8);
      h16x8 gp1, gp2, vp1, vp2;
      const float* st = p.in[I_SFFN] + (size_t)(k.seq - 8) * 11264;
      conv_prev16(TG, row, c8, k, st + cgc, 5632, gp1, gp2);
      conv_prev16(TV, row, c8, k, st + cvc, 5632, vp1, vp2);
      const h16x8 cgh = g0 * gp2 + g1 * gp1 + g2 * gc;
      const h16x8 cvh = v0 * vp2 + v1 * vp1 + v2 * vc;
      const F8 cg_ = cvtf(cgh);
      F8 sl;
      sl.a = f32x4{cg_.a.x * sigm(cg_.a.x), cg_.a.y * sigm(cg_.a.y), cg_.a.z * sigm(cg_.a.z), cg_.a.w * sigm(cg_.a.w)};
      sl.b = f32x4{cg_.b.x * sigm(cg_.b.x), cg_.b.y * sigm(cg_.b.y), cg_.b.z * sigm(cg_.b.z), cg_.b.w * sigm(cg_.b.w)};
      *(h16x8*)(HH + (size_t)m * DFF + n0 + c8) = cvth(sl) * cvh;
      if (k.t >= k.T - 2) {
        float* fo = p.out + O_FFN + (size_t)k.seq * 11264 + (k.t - (k.T - 2)) * 5632;
        st32(fo + cgc, cvtf(gc)); st32(fo + cvc, cvtf(vc));
      }
    }
    __syncthreads();
  }
}

FI void phase8_epi(h16* X1, const h16* T, int mbase, int n0) {
  const int tid = threadIdx.x, c8 = (tid & 15) * 8, r0 = tid >> 4, n = n0 + c8;
#pragma unroll 1
  for (int i = 0; i < 8; ++i) {
    const int row = r0 + 16 * i, m = mbase + row;
    h16* q = X1 + (size_t)m * DM + n;
    const F8 a = ld16(T + row * 128 + c8), x = ld16(q);
    F8 o; o.a = x.a + a.a; o.b = x.b + a.b;
    st16(q, o);
  }
}
FI void phase8(const Params& p, char* lds) {
  const h16* HH = (const h16*)(p.ws + WS_B);
  const h16* WDN = (const h16*)(p.ws + WS_WDN);
  h16* X1 = (h16*)(p.ws + WS_A);
  h16* T0 = (h16*)lds; h16* T1 = T0 + 16384;
  const int G = gridDim.x, NP = 4 * NMT;
  const int nfull = (NP / G) * G;
  for (int it = blockIdx.x; it < nfull; it += G) {
    const int jp = it / NMT, mt = it - jp * NMT;
    const int mbase = mt * 128, n0 = jp * 256;
    {
      f32x4 acc[4][4], acc2[4][4];
      zero_acc(acc); zero_acc(acc2);
      mainloop2(acc, acc2, HH, DFF, mbase, WDN + (size_t)n0 * DFF, WDN + (size_t)(n0 + 128) * DFF, DFF, DFF, lds);
      stage16(acc, T0); stage16(acc2, T1);
    }
    __syncthreads();
    phase8_epi(X1, T0, mbase, n0);
    phase8_epi(X1, T1, mbase, n0 + 128);
    __syncthreads();
  }
  const int nrest = (NP - nfull) * 2;
  for (int w = blockIdx.x; w < nrest; w += G) {
    const int it = nfull + (w >> 1);
    const int jp = it / NMT, mt = it - jp * NMT;
    const int mbase = mt * 128, n0 = jp * 256 + (w & 1) * 128;
    {
      f32x4 acc[4][4];
      zero_acc(acc);
      mainloop(acc, HH, DFF, mbase, WDN + (size_t)n0 * DFF, DFF, DFF, lds);
      stage16(acc, T0);
    }
    __syncthreads();
    phase8_epi(X1, T0, mbase, n0);
    __syncthreads();
  }
}

constexpr int NPHASE = 11;

#define XB_TMO      128
#define XB_XCNT(j)  (256  + 64 * (j))
#define XB_XSUB(j)  (1280 + 64 * (j))
#define XB_XGEN(j)  (2304 + 64 * (j))
#define XB_TOP      3328
#define XB_TOPGEN   3392
#define XCD_BAR_WORDS 3456
#define XB_SPIN_CAP (1u << 18)
FI unsigned xb_ld(unsigned* p)              { return __hip_atomic_load(p, __ATOMIC_RELAXED, __HIP_MEMORY_SCOPE_AGENT); }
FI unsigned xb_add(unsigned* p, unsigned v) { return __hip_atomic_fetch_add(p, v, __ATOMIC_RELAXED, __HIP_MEMORY_SCOPE_AGENT); }
FI unsigned xb_xcc_id() { return (unsigned)__builtin_amdgcn_s_getreg((3 << 11) | 20) & 0xFu; }
#define XB_SPIN(cond, bar) do { unsigned _sp = 0; while (cond) { __builtin_amdgcn_s_sleep(1); \
    if ((++_sp & 255u) == 0u) { if (xb_ld(&(bar)[XB_TMO])) break; if (_sp > XB_SPIN_CAP) { atomicAdd(&(bar)[XB_TMO], 1u); break; } } } } while (0)
struct XcdBarrier { unsigned* bar; unsigned x; volatile unsigned* st; };
FI XcdBarrier xcd_barrier_post(unsigned* bar, volatile unsigned* st) {
  XcdBarrier b; b.bar = bar; b.x = xb_xcc_id(); b.st = st;
  if (threadIdx.x == 0) (void)xb_add(&bar[XB_XCNT(b.x)], 1u);
  return b;
}
FI void xcd_barrier_complete(unsigned* bar, unsigned x, unsigned& nloc, unsigned& nx) {
  const unsigned G = gridDim.x * gridDim.y * gridDim.z;
  unsigned sum, cnt, mine, sp = 0u;
  for (;;) {
    sum = 0u; cnt = 0u; mine = 0u;
#pragma unroll
    for (unsigned j = 0; j < 16; ++j) { const unsigned c = xb_ld(&bar[XB_XCNT(j)]); sum += c; cnt += (c > 0u) ? 1u : 0u; mine = (j == x) ? c : mine; }
    if (sum == G) break;
    __builtin_amdgcn_s_sleep(1);
    if ((++sp & 255u) == 0u) { if (xb_ld(&bar[XB_TMO])) break; if (sp > XB_SPIN_CAP) { atomicAdd(&bar[XB_TMO], 1u); break; } }
  }
  nloc = mine > 0u ? mine : 1u; nx = cnt > 0u ? cnt : 1u;
}
FI void xcd_barrier(const XcdBarrier& b) {
  asm volatile("s_waitcnt vmcnt(0)" ::: "memory");
  __syncthreads();
  if (threadIdx.x == 0) {
    unsigned* bar = b.bar;
    __builtin_amdgcn_s_waitcnt(0);
    unsigned nloc = b.st[0], nx = b.st[1];
    if (nloc == 0u) { xcd_barrier_complete(bar, b.x, nloc, nx); b.st[0] = nloc; b.st[1] = nx; }
    const unsigned old = xb_add(&bar[XB_XSUB(b.x)], 1u);
    const unsigned gen = old / nloc;
    if (old + 1u == (gen + 1u) * nloc) {
      __builtin_amdgcn_fence(__ATOMIC_RELEASE, "agent");
      asm volatile("s_waitcnt vmcnt(0)" ::: "memory");
      const unsigned og = xb_add(&bar[XB_TOP], 1u);
      const unsigned tg = og / nx;
      if (og + 1u == (tg + 1u) * nx) xb_add(&bar[XB_TOPGEN], 1u);
      else XB_SPIN(xb_ld(&bar[XB_TOPGEN]) == tg, bar);
      __builtin_amdgcn_fence(__ATOMIC_ACQUIRE, "agent");
      xb_add(&bar[XB_XGEN(b.x)], 1u);
      asm volatile("s_waitcnt vmcnt(0)" ::: "memory");
    } else {
      XB_SPIN(xb_ld(&bar[XB_XGEN(b.x)]) == gen, bar);
      __builtin_amdgcn_fence(__ATOMIC_ACQUIRE, "agent");
      asm volatile("s_waitcnt vmcnt(0)" ::: "memory");
    }
  }
  __syncthreads();
}

template <int PH> FI void run_phase(const Params& p, char* lds) {
  if (PH == 0) phase0(p, lds);
  if (PH == 1) phase1(p, lds);
  if (PH == 2) phaseA(p, lds);
  if (PH == 3) phase3(p, lds);
  if (PH == 4) phase3b(p, lds);
  if (PH == 5) phase4(p, lds);
  if (PH == 6) phase5(p, lds);
  if (PH == 7) rms_rows(p, 1, (const float*)(p.ws + WS_A), p.in[I_N2G], (h16*)(p.ws + WS_D), blockIdx.x * 4 + (threadIdx.x >> 6), gridDim.x * 4);
  if (PH == 8) phase7(p, lds);
  if (PH == 9) phase8(p, lds);
  if (PH == 10) rms_rows(p, 2, (const float*)(p.ws + WS_A), p.in[I_FNG], nullptr, blockIdx.x * 4 + (threadIdx.x >> 6), gridDim.x * 4);
}

template <int PH> __global__ void __launch_bounds__(256, 1) mega_one(Params p) {
  __shared__ __attribute__((aligned(16))) char lds[77824 + 16];
  run_phase<PH>(p, lds);
}

#if N_LAUNCH_MODE == 1
__global__ void __launch_bounds__(256, 2) mega(Params p) {
  __shared__ __attribute__((aligned(16))) char lds[77824 + 16];
  volatile unsigned* st = (volatile unsigned*)(lds + 77824);
  if (threadIdx.x < 4) st[threadIdx.x] = 0u;
  __syncthreads();
  if (p.ph_lo < 0) cg::this_grid().sync();
  XcdBarrier xb = xcd_barrier_post((unsigned*)(p.ws + WS_END), st);
  run_phase<0>(p, lds); xcd_barrier(xb);
  run_phase<1>(p, lds); xcd_barrier(xb);
  run_phase<2>(p, lds); xcd_barrier(xb);
  run_phase<3>(p, lds); xcd_barrier(xb);
  run_phase<4>(p, lds); xcd_barrier(xb);
  run_phase<5>(p, lds); xcd_barrier(xb);
  run_phase<6>(p, lds); xcd_barrier(xb);
  run_phase<7>(p, lds); xcd_barrier(xb);
  run_phase<8>(p, lds); xcd_barrier(xb);
  run_phase<9>(p, lds); xcd_barrier(xb);
  run_phase<10>(p, lds);
}
#endif

extern "C" void kernel_launch(void* const* d_in, const int* in_sizes, int n_in, void* d_out, int out_size,
                              void* d_ws, size_t ws_size, hipStream_t stream) {
  static int grid = 0;
  if (!grid) {
    int dev = 0, cus = 0, per_cu = 0;
    (void)hipGetDevice(&dev);
    (void)hipDeviceGetAttribute(&cus, hipDeviceAttributeMultiprocessorCount, dev);
#if N_LAUNCH_MODE == 1
    (void)hipOccupancyMaxActiveBlocksPerMultiprocessor(&per_cu, mega, 256, 0);
#else
    per_cu = 2;
#endif
    if (per_cu < 1) per_cu = 1;
    if (per_cu > 2) per_cu = 2;
    grid = cus * per_cu;
    if (ws_size < WS_RK + 1179648) fprintf(stderr, "workspace too small: %zu < %zu\n", ws_size, (size_t)WS_END);
  }
  Params p{};
  for (int i = 0; i < 30; ++i) p.in[i] = (const float*)d_in[i];
  p.out = (float*)d_out;
  p.ws = (char*)d_ws;
#if N_LAUNCH_MODE == 1
  p.ph_lo = 0; p.ph_hi = NPHASE;
  (void)hipMemsetAsync((char*)d_ws + WS_END, 0, XCD_BAR_WORDS * 4, stream);
  void* args[] = {&p};
  hipError_t e = hipLaunchCooperativeKernel((void*)mega, dim3(grid), dim3(256), args, 0, stream);
  if (e != hipSuccess) fprintf(stderr, "cooperative launch failed: %s (grid %d)\n", hipGetErrorString(e), grid);
#else
  p.ph_lo = 0; p.ph_hi = NPHASE;
  hipLaunchKernelGGL(mega_one<0>, dim3(grid), dim3(256), 0, stream, p);
  hipLaunchKernelGGL(mega_one<1>, dim3(grid), dim3(256), 0, stream, p);
  hipLaunchKernelGGL(mega_one<2>, dim3(grid), dim3(256), 0, stream, p);
  hipLaunchKernelGGL(mega_one<3>, dim3(grid), dim3(256), 0, stream, p);
  hipLaunchKernelGGL(mega_one<4>, dim3(grid), dim3(256), 0, stream, p);
  hipLaunchKernelGGL(mega_one<5>, dim3(grid), dim3(256), 0, stream, p);
  hipLaunchKernelGGL(mega_one<6>, dim3(grid), dim3(256), 0, stream, p);
  hipLaunchKernelGGL(mega_one<7>, dim3(grid), dim3(256), 0, stream, p);
  hipLaunchKernelGGL(mega_one<8>, dim3(grid), dim3(256), 0, stream, p);
  hipLaunchKernelGGL(mega_one<9>, dim3(grid), dim3(256), 0, stream, p);
  hipLaunchKernelGGL(mega_one<10>, dim3(grid), dim3(256), 0, stream, p);
#endif
}
```
